# Optimizing an MI355X kernel written in HIP

```python
import math
import jax, jax.numpy as jnp
from jax import lax
import numpy as np

D_MODEL = 2048
BATCH = 8
SEQ = 2048
DEPTH = 1

HEAD_DIM = 128
NAT_WIDTH = D_MODEL // 2
DIFF_WIDTH = D_MODEL - NAT_WIDTH
N_NAT_HEADS = NAT_WIDTH // HEAD_DIM
N_DIFF_HEADS = DIFF_WIDTH // (2 * HEAD_DIM)
MIX_WIDTH = NAT_WIDTH + DIFF_WIDTH
IN_WIDTH = 3 * NAT_WIDTH + 3 * DIFF_WIDTH
GRID_W = 64
NAT_KR_MAX = 8
NAT_KC = 16
N_BUCKETS = 32
MAX_DISTANCE = 128
Q_BLOCK = 128
N_EXPERTS = 32
TOP_K = 4
D_FF = D_MODEL
SWIGLU_LIMIT = 7.0
SWIGLU_ALPHA = 1.702
RMS_EPS = 1e-6
NEG_INF = -1e30

kernel_name = 'hybrid_natten_diffattn_moe_block'


def rms_norm(x, g):
    xf = x.astype(jnp.float32)
    y = xf * lax.rsqrt(jnp.mean(xf * xf, axis=-1, keepdims=True) + RMS_EPS)
    return (y * g.astype(jnp.float32)).astype(x.dtype)


def t5_bucket(rel):
    nb = N_BUCKETS // 2
    max_exact = nb // 2
    ret = jnp.where(rel > 0, nb, 0)
    n = jnp.abs(rel)
    nf = jnp.maximum(n, 1).astype(jnp.float32)
    large = max_exact + (jnp.log(nf / max_exact) / math.log(MAX_DISTANCE / max_exact)
                         * (nb - max_exact)).astype(jnp.int32)
    large = jnp.minimum(large, nb - 1)
    return ret + jnp.where(n < max_exact, n, large)


def neighbourhood_attention(q, k, v, rpb):
    B, S, H, Dh = q.shape
    rows = S // GRID_W
    kr = min(NAT_KR_MAX, rows)
    scale = Dh ** -0.5

    def grid(t):
        return t.reshape(B, rows, GRID_W, H, Dh).transpose(0, 3, 1, 2, 4)

    qg, kg, vg = grid(q), grid(k), grid(v)
    r = jnp.arange(rows)
    row_start = jnp.clip(r - kr // 2, 0, rows - kr)
    row_idx = row_start[:, None] + jnp.arange(kr)[None, :]
    k_band = kg[:, :, row_idx]
    v_band = vg[:, :, row_idx]
    col = jnp.arange(GRID_W)
    col_start = jnp.clip(col - NAT_KC // 2, 0, GRID_W - NAT_KC)
    col_mask = (col[None, :] >= col_start[:, None]) & (col[None, :] < col_start[:, None] + NAT_KC)
    row_off = row_idx - r[:, None] + (NAT_KR_MAX - 1)
    col_off = jnp.clip(col[None, :] - col[:, None], -(NAT_KC - 1), NAT_KC - 1) + (NAT_KC - 1)
    bias = jnp.take(rpb[:, row_off], col_off, axis=-1)
    bias = bias.transpose(0, 1, 3, 2, 4).astype(jnp.float32)
    logits = jnp.einsum('bhrqd,bhrkcd->bhrqkc', qg, k_band).astype(jnp.float32) * scale + bias[None]
    logits = jnp.where(col_mask[:, None, :], logits, NEG_INF)
    p = jax.nn.softmax(logits, axis=(-2, -1))
    out = jnp.einsum('bhrqkc,bhrkcd->bhrqd', p.astype(v.dtype), v_band)
    return out.transpose(0, 2, 3, 1, 4).reshape(B, S, H * Dh)


def diff_attention(q, k, v, rel_table, lambda_full, sub_g, lambda_init):
    B, S, H, _, Dh = q.shape
    nblk = S // Q_BLOCK
    scale = Dh ** -0.5
    qb = q.reshape(B, nblk, Q_BLOCK, H, 2, Dh).transpose(1, 0, 3, 4, 2, 5)
    kt = k.transpose(0, 2, 3, 1, 4)
    vt = v.transpose(0, 2, 1, 3)
    kpos = jnp.arange(S, dtype=jnp.int32)

    def block(args):
        q_blk, start = args
        qpos = start + jnp.arange(Q_BLOCK, dtype=jnp.int32)
        bias = rel_table[t5_bucket(kpos[None, :] - qpos[:, None])]
        bias = bias.transpose(2, 0, 1).astype(jnp.float32)
        logits = jnp.einsum('bhpqd,bhpkd->bhpqk', q_blk, kt).astype(jnp.float32) * scale
        p = jax.nn.softmax(logits + bias[None, :, None], axis=-1)
        a = p[:, :, 0] - lambda_full * p[:, :, 1]
        return jnp.einsum('bhqk,bhkd->bhqd', a.astype(vt.dtype), vt)

    starts = jnp.arange(nblk, dtype=jnp.int32) * Q_BLOCK
    o = lax.map(block, (qb, starts))
    o = rms_norm(o, sub_g) * (1.0 - lambda_init)
    return o.transpose(1, 0, 3, 2, 4).reshape(B, S, H * 2 * Dh)


def moe(h, router_w, router_b, w_gu, b_gu, w_dn, b_dn):
    B, S, D = h.shape
    t = h.reshape(-1, D)
    logits = (t @ router_w).astype(jnp.float32) + router_b.astype(jnp.float32)
    top_vals, top_idx = lax.top_k(logits, TOP_K)
    gates = jax.nn.softmax(top_vals, axis=-1)
    flat_e = top_idx.reshape(-1)
    order = jnp.argsort(flat_e)
    tok = order // TOP_K
    e_sorted = flat_e[order]
    g_sorted = gates.reshape(-1)[order]
    group_sizes = jnp.bincount(flat_e, length=N_EXPERTS).astype(jnp.int32)
    xs = t[tok]
    gu = lax.ragged_dot(xs, w_gu, group_sizes) + b_gu[e_sorted]
    gate = jnp.minimum(gu[:, :D_FF], SWIGLU_LIMIT)
    up = jnp.clip(gu[:, D_FF:], -SWIGLU_LIMIT, SWIGLU_LIMIT)
    act = (up + 1.0) * gate * jax.nn.sigmoid(gate * SWIGLU_ALPHA)
    y = lax.ragged_dot(act, w_dn, group_sizes) + b_dn[e_sorted]
    y = y * g_sorted[:, None].astype(y.dtype)
    out = jnp.zeros_like(t).at[tok].add(y)
    return out.reshape(B, S, D)


def setup_inputs(seed: int = 0) -> dict:
    key = jax.random.key(seed)
    ks = jax.random.split(key, 24)

    def nrm(k, shape, s):
        return jax.random.normal(k, shape, dtype=jnp.float32) * s

    def gain(k, shape):
        return 1.0 + nrm(k, shape, 0.01)

    return {
        'x': nrm(ks[0], (BATCH, SEQ, D_MODEL), 1.0),
        'c': nrm(ks[1], (BATCH, D_MODEL), 1.0),
        'w_ada': nrm(ks[2], (DEPTH, D_MODEL, 6 * D_MODEL), 0.5 * D_MODEL ** -0.5),
        'b_ada': nrm(ks[3], (DEPTH, 6 * D_MODEL), 0.01),
        'norm1_g': gain(ks[4], (DEPTH, D_MODEL)),
        'w_in': nrm(ks[5], (DEPTH, D_MODEL, IN_WIDTH), D_MODEL ** -0.5),
        'nat_q_g': gain(ks[6], (DEPTH, HEAD_DIM)),
        'nat_k_g': gain(ks[7], (DEPTH, HEAD_DIM)),
        'nat_rpb': nrm(ks[8], (DEPTH, N_NAT_HEADS, 2 * NAT_KR_MAX - 1, 2 * NAT_KC - 1), 0.1),
        'diff_q_g': gain(ks[9], (DEPTH, HEAD_DIM)),
        'diff_k_g': gain(ks[10], (DEPTH, HEAD_DIM)),
        'diff_lambda': nrm(ks[11], (DEPTH, 4, HEAD_DIM), 0.1),
        'diff_sub_g': gain(ks[12], (DEPTH, 2 * HEAD_DIM)),
        'rel_bias_table': nrm(ks[13], (N_BUCKETS, N_DIFF_HEADS), 0.1),
        'w_out': nrm(ks[14], (DEPTH, MIX_WIDTH, D_MODEL), MIX_WIDTH ** -0.5),
        'norm2_g': gain(ks[15], (DEPTH, D_MODEL)),
        'router_w': nrm(ks[16], (DEPTH, D_MODEL, N_EXPERTS), D_MODEL ** -0.5),
        'router_b': nrm(ks[17], (DEPTH, N_EXPERTS), 0.01),
        'w_gate_up': nrm(ks[18], (DEPTH, N_EXPERTS, D_MODEL, 2 * D_FF), D_MODEL ** -0.5),
        'b_gate_up': nrm(ks[19], (DEPTH, N_EXPERTS, 2 * D_FF), 0.01),
        'w_down': nrm(ks[20], (DEPTH, N_EXPERTS, D_FF, D_MODEL), D_FF ** -0.5),
        'b_down': nrm(ks[21], (DEPTH, N_EXPERTS, D_MODEL), 0.01),
    }


def reference(x, c, w_ada, b_ada, norm1_g, w_in, nat_q_g, nat_k_g, nat_rpb, diff_q_g, diff_k_g,
              diff_lambda, diff_sub_g, rel_bias_table, w_out, norm2_g, router_w, router_b,
              w_gate_up, b_gate_up, w_down, b_down):
    B, S, D = x.shape
    for l in range(DEPTH):
        lambda_init = 0.8 - 0.6 * math.exp(-0.3 * l)
        mod = jax.nn.silu(c) @ w_ada[l] + b_ada[l]
        shift1, scale1, gate1, shift2, scale2, gate2 = jnp.split(mod[:, None, :], 6, axis=-1)

        h = rms_norm(x, norm1_g[l]) * (1.0 + scale1) + shift1
        proj = h @ w_in[l]
        nq, nk, nv, dq, dk, dv = jnp.split(
            proj, [NAT_WIDTH, 2 * NAT_WIDTH, 3 * NAT_WIDTH, 3 * NAT_WIDTH + DIFF_WIDTH,
                   3 * NAT_WIDTH + 2 * DIFF_WIDTH], axis=-1)
        nq = rms_norm(nq.reshape(B, S, N_NAT_HEADS, HEAD_DIM), nat_q_g[l])
        nk = rms_norm(nk.reshape(B, S, N_NAT_HEADS, HEAD_DIM), nat_k_g[l])
        nv = nv.reshape(B, S, N_NAT_HEADS, HEAD_DIM)
        nat_out = neighbourhood_attention(nq, nk, nv, nat_rpb[l])

        dq = rms_norm(dq.reshape(B, S, N_DIFF_HEADS, 2, HEAD_DIM), diff_q_g[l])
        dk = rms_norm(dk.reshape(B, S, N_DIFF_HEADS, 2, HEAD_DIM), diff_k_g[l])
        dv = dv.reshape(B, S, N_DIFF_HEADS, 2 * HEAD_DIM)
        lam = diff_lambda[l].astype(jnp.float32)
        lambda_full = (jnp.exp(jnp.sum(lam[0] * lam[1])) - jnp.exp(jnp.sum(lam[2] * lam[3]))
                       + lambda_init)
        diff_out = diff_attention(dq, dk, dv, rel_bias_table, lambda_full, diff_sub_g[l],
                                  lambda_init)

        mix = jnp.concatenate([nat_out, diff_out], axis=-1) @ w_out[l]
        x = x + gate1 * mix

        h2 = rms_norm(x, norm2_g[l]) * (1.0 + scale2) + shift2
        x = x + gate2 * moe(h2, router_w[l], router_b[l], w_gate_up[l], b_gate_up[l],
                            w_down[l], b_down[l])
    return x
```

```cpp
#define STAGE 9
#include <hip/hip_runtime.h>
#include <cstdint>
#include <cstdio>

#define GAS __attribute__((address_space(1)))
#define LAS __attribute__((address_space(3)))
typedef unsigned short bf16_t;
typedef short bf16x8 __attribute__((ext_vector_type(8)));
typedef short s16x4 __attribute__((ext_vector_type(4)));
typedef float f32x2 __attribute__((ext_vector_type(2)));
typedef float f32x4 __attribute__((ext_vector_type(4)));
typedef float f32x16 __attribute__((ext_vector_type(16)));
typedef unsigned u32x4 __attribute__((ext_vector_type(4)));
typedef unsigned u32x2 __attribute__((ext_vector_type(2)));

constexpr int D = 2048, NB = 8, S = 2048, M = NB * S, HD = 128;
constexpr int INW = 6144, NE = 32, DFF = 2048;
constexpr float RMS_EPS = 1e-6f;
constexpr size_t MiB = 1u << 20;
constexpr int MAXSLOT = 73728, MAXTILE = MAXSLOT / 256;
constexpr int P2_RR = 8;
constexpr int NCONV = 64;
constexpr int CONV_E0 = 0, CONV_E2 = 3;
constexpr int CONV_SLOTS = 4;
constexpr int GU_SPLIT = 32 * 4096 * CONV_E0 / 8, DN_SPLIT = 32 * 2048 * CONV_E0 / 8, GU_SPLIT3 = 32 * 4096 * (CONV_E0 + CONV_E2) / 8, DN_SPLIT3 = 32 * 2048 * (CONV_E0 + CONV_E2) / 8;
constexpr int YSH = 4;
constexpr int WSH = 5;
constexpr size_t WS_CTL = 0, CTL_ZERO_BYTES = 1 * MiB;
constexpr size_t WS_MODP = 1 * MiB;
constexpr size_t WS_MOD = 5 * MiB;
constexpr size_t WS_MISC = 6 * MiB;
constexpr size_t WS_GATE = 7 * MiB;
constexpr size_t WS_LIST = 8 * MiB;
constexpr size_t WS_ROWCODE = 10 * MiB;
constexpr size_t WS_TILEE = 11 * MiB;
constexpr size_t WS_WIN = 16 * MiB;
constexpr size_t WS_WO = 40 * MiB;
constexpr size_t WS_XN = 48 * MiB;
constexpr size_t WS_QKV = 112 * MiB;
constexpr size_t WS_MIX = 304 * MiB;
constexpr size_t WS_H2 = 368 * MiB;
constexpr size_t WS_STASH = 432 * MiB;
constexpr size_t WS_WGU = 560 * MiB;
constexpr size_t WS_WDN = 1072 * MiB;
constexpr size_t WS_ACT = 1328 * MiB;
constexpr size_t WS_Y = 1616 * MiB;
constexpr size_t WS_TEST = 2048 * MiB;
constexpr int CW_CNT = 0;
constexpr int CW_BAR = 4096;
constexpr int RING_OFF = 0, RING_BYTES = 131072;
constexpr int EXCH_OFF = RING_BYTES;
constexpr int GTAB_OFF = EXCH_OFF + 8192;
constexpr int LDSCTL_OFF = GTAB_OFF + 2048;
constexpr int EPI_OFF = LDSCTL_OFF + 256;
constexpr int LDS_BYTES = EPI_OFF + 12288;
static_assert(EPI_OFF + 12288 <= LDS_BYTES && LDS_BYTES <= 163840, "LDS map");

#define RLX_AGENT __ATOMIC_RELAXED, __HIP_MEMORY_SCOPE_AGENT
#define LDS_WAIT() asm volatile("s_waitcnt lgkmcnt(0)" ::: "memory")
#define VM_WAIT() asm volatile("s_waitcnt vmcnt(0)" ::: "memory")

__device__ __forceinline__ unsigned cvt_pk_bf16(float lo, float hi) { unsigned r; asm volatile("v_cvt_pk_bf16_f32 %0, %1, %2" : "=v"(r) : "v"(lo), "v"(hi)); return r; }
__device__ __forceinline__ unsigned pk4_fp8(float a, float b, float c, float d) { int r = __builtin_amdgcn_cvt_pk_fp8_f32(a, b, 0, false); r = __builtin_amdgcn_cvt_pk_fp8_f32(c, d, r, true); return (unsigned)r; }
__device__ __forceinline__ float bf2f(unsigned short b) { return __uint_as_float(((unsigned)b) << 16); }
__device__ __forceinline__ float wave_sum(float v) {
#pragma unroll
    for (int o = 32; o >= 1; o >>= 1) v += __shfl_xor(v, o);
    return v;
}
__device__ __forceinline__ float wave_max(float v) {
#pragma unroll
    for (int o = 32; o >= 1; o >>= 1) v = fmaxf(v, __shfl_xor(v, o));
    return v;
}

#define XB_TMO      128
#define XB_XCNT(j)  (256  + 64 * (j))
#define XB_XSUB(j)  (1280 + 64 * (j))
#define XB_XGEN(j)  (2304 + 64 * (j))
#define XB_TOP      3328
#define XB_TOPGEN   3392
#define XCD_BAR_WORDS 3456
#define XB_SPIN_CAP (1u << 18)
__device__ __forceinline__ unsigned xb_ld(unsigned* p)              { return __hip_atomic_load(p, __ATOMIC_RELAXED, __HIP_MEMORY_SCOPE_AGENT); }
__device__ __forceinline__ unsigned xb_add(unsigned* p, unsigned v) { return __hip_atomic_fetch_add(p, v, __ATOMIC_RELAXED, __HIP_MEMORY_SCOPE_AGENT); }
__device__ __forceinline__ unsigned xb_xcc_id() { return (unsigned)__builtin_amdgcn_s_getreg((3 << 11) | 20) & 0xFu; }
#define XB_SPIN(cond, bar) do { unsigned _sp = 0; while (cond) { __builtin_amdgcn_s_sleep(1); \
    if ((++_sp & 255u) == 0u) { if (xb_ld(&(bar)[XB_TMO])) break; if (_sp > XB_SPIN_CAP) { atomicAdd(&(bar)[XB_TMO], 1u); break; } } } } while (0)
struct XcdBarrier { unsigned* bar; unsigned x; volatile LAS unsigned* st; };
__device__ __forceinline__ XcdBarrier xcd_barrier_post(unsigned* bar, volatile LAS unsigned* st) {
    XcdBarrier b; b.bar = bar; b.x = xb_xcc_id(); b.st = st;
    if (threadIdx.x == 0) (void)xb_add(&bar[XB_XCNT(b.x)], 1u);
    return b;
}
__device__ __forceinline__ void xcd_barrier_complete(unsigned* bar, unsigned x, unsigned& nloc, unsigned& nx) {
    const unsigned G = gridDim.x * gridDim.y * gridDim.z;
    unsigned sum, cnt, mine, sp = 0u;
    for (;;) {
        sum = 0u; cnt = 0u; mine = 0u;
#pragma unroll
        for (unsigned j = 0; j < 16; ++j) { const unsigned c = xb_ld(&bar[XB_XCNT(j)]); sum += c; cnt += (c > 0u) ? 1u : 0u; mine = (j == x) ? c : mine; }
        if (sum == G) break;
        __builtin_amdgcn_s_sleep(1);
        if ((++sp & 255u) == 0u) { if (xb_ld(&bar[XB_TMO])) break; if (sp > XB_SPIN_CAP) { atomicAdd(&bar[XB_TMO], 1u); break; } }
    }
    nloc = mine > 0u ? mine : 1u; nx = cnt > 0u ? cnt : 1u;
}
__device__ __forceinline__ void xcd_barrier(const XcdBarrier& b) {
    asm volatile("s_waitcnt vmcnt(0)" ::: "memory");
    __syncthreads();
    if (threadIdx.x == 0) {
        unsigned* bar = b.bar;
        __builtin_amdgcn_s_waitcnt(0);
        unsigned nloc = b.st[0], nx = b.st[1];
        if (nloc == 0u) { xcd_barrier_complete(bar, b.x, nloc, nx); b.st[0] = nloc; b.st[1] = nx; }
        const unsigned old = xb_add(&bar[XB_XSUB(b.x)], 1u);
        const unsigned gen = old / nloc;
        if (old + 1u == (gen + 1u) * nloc) {
            __builtin_amdgcn_fence(__ATOMIC_RELEASE, "agent");
            asm volatile("s_waitcnt vmcnt(0)" ::: "memory");
            const unsigned og = xb_add(&bar[XB_TOP], 1u);
            const unsigned tg = og / nx;
            if (og + 1u == (tg + 1u) * nx) xb_add(&bar[XB_TOPGEN], 1u);
            else XB_SPIN(xb_ld(&bar[XB_TOPGEN]) == tg, bar);
            __builtin_amdgcn_fence(__ATOMIC_ACQUIRE, "agent");
            xb_add(&bar[XB_XGEN(b.x)], 1u);
            asm volatile("s_waitcnt vmcnt(0)" ::: "memory");
        } else {
            XB_SPIN(xb_ld(&bar[XB_XGEN(b.x)]) == gen, bar);
            __builtin_amdgcn_fence(__ATOMIC_ACQUIRE, "agent");
            asm volatile("s_waitcnt vmcnt(0)" ::: "memory");
        }
    }
    __syncthreads();
}
namespace pg8 {
constexpr int BM = 256, BK = 64, HALF = 128, HTB = HALF * BK * 2, STAGE_BYTES = 8 * HTB, NXCD = 8, WGM = 8;
__host__ __device__ __forceinline__ int lds_byte(int r, int c) { const int st = (r >> 4) * 2 + (c >> 5), rr = r & 15, cc = c & 31, ob = rr * 64 + cc * 2; return st * 1024 + (ob ^ (((ob >> 9) & 1) << 5)); }
__host__ __device__ __forceinline__ void stage_rc(int b, int& R, int& C) { const int st = b / 1024, sb = b % 1024, swz = sb ^ (((sb >> 9) & 1) << 5); R = (st >> 1) * 16 + swz / 64; C = (st & 1) * 32 + (swz % 64) / 2; }
__host__ __device__ __forceinline__ int perm32(int rho) { const int n = rho >> 4, i = rho & 15; return 8 * (i >> 2) + 4 * n + (i & 3); }

struct Unit { int pm, pn, e; };

struct StaticOrder {
    int nM, nN, nwg, G, c, lo, hi;
    __device__ void init(int nM_, int nN_, int G_, int c_) { nM = nM_; nN = nN_; nwg = nM * nN; G = G_; c = c_; lo = 0; hi = nwg; }
    __device__ bool next(int i, Unit& u) const {
        const long L = (long)lo + (long)i * G + c; if (L >= hi) return false;
        int wgid = (int)L; { const int q = nwg / NXCD, r = nwg % NXCD, xcd = wgid % NXCD, off = wgid / NXCD; wgid = (xcd < r ? xcd * (q + 1) : r * (q + 1) + (xcd - r) * q) + off; }
        const int nig = WGM * nN, gid = wgid / nig, fm = gid * WGM, gsz = (nM - fm) < WGM ? (nM - fm) : WGM;
        u.pm = fm + ((wgid % nig) % gsz); u.pn = (wgid % nig) / gsz; u.e = 0; return true;
    }
};
struct DenseSched {
    static constexpr bool VARA = false;
    const void* A; const void* Bt; int RB; StaticOrder ord;
    __device__ __forceinline__ bool next(int i, Unit& u) const { return ord.next(i, u); }
    __device__ __forceinline__ const char* a_base(const Unit& u) const { return (const char*)A + (size_t)u.pm * BM * RB; }
    __device__ __forceinline__ const char* b_base(const Unit& u) const { return (const char*)Bt + (size_t)u.pn * BM * RB; }
    __device__ __forceinline__ int b_pitch() const { return RB; }
    __device__ __forceinline__ int b_kstep() const { return BK * 2; }
    __device__ __forceinline__ void a_voff(const Unit&, const int (&R)[2], const int (&C)[2], unsigned (&va)[2][2]) const {
#pragma unroll
        for (int h = 0; h < 2; ++h)
#pragma unroll
            for (int i = 0; i < 2; ++i) va[h][i] = (unsigned)((h * HALF + R[i]) * RB + C[i] * 2);
    }
};
template <bool GATHER> struct MoeSched {
    static constexpr bool VARA = true;
    const void* A; const void* Bt; int RB; int NperE; StaticOrder ord;
    const LAS int* tile_e; const LAS int* base; const LAS int* cnt; const int* list;
    __device__ __forceinline__ bool next(int i, Unit& u) const { if (!ord.next(i, u)) return false; u.e = tile_e[u.pm]; return true; }
    __device__ __forceinline__ const char* a_base(const Unit& u) const { return GATHER ? (const char*)A : (const char*)A + (size_t)u.pm * BM * RB; }
    __device__ __forceinline__ const char* b_base(const Unit& u) const { return (const char*)Bt + ((size_t)u.e * (NperE / BM) + (size_t)u.pn) * (size_t)(RB / 128) * 32768; }
    __device__ __forceinline__ int b_pitch() const { return 128; }
    __device__ __forceinline__ int b_kstep() const { return 32768; }
    __device__ __forceinline__ void a_voff(const Unit& u, const int (&R)[2], const int (&C)[2], unsigned (&va)[2][2]) const {
#pragma unroll
        for (int h = 0; h < 2; ++h)
#pragma unroll
            for (int i = 0; i < 2; ++i) {
                if (GATHER) { const int pos = u.pm * BM + h * HALF + R[i] - base[u.e]; const int code = pos < cnt[u.e] ? list[(u.e * 16384 + pos) * 2] : 0;
                    va[h][i] = (unsigned)((code >> 2) * RB + C[i] * 2); }
                else va[h][i] = (unsigned)((h * HALF + R[i]) * RB + C[i] * 2);
            }
    }
    __device__ __forceinline__ void a_voff_slot(const Unit& u, const int (&R)[2], const int (&C)[2], unsigned (&va)[2][2], const LAS unsigned char* slot) const {
        const int nvalid = cnt[u.e] - (u.pm * BM - base[u.e]); const LAS u32x2* le = (const LAS u32x2*)(slot + 1024);
#pragma unroll
        for (int h = 0; h < 2; ++h)
#pragma unroll
            for (int i = 0; i < 2; ++i) {
                if (GATHER) { const int rl = h * HALF + R[i]; const int code = rl < nvalid ? (int)le[rl].x : 0;
                    va[h][i] = (unsigned)((code >> 2) * RB + C[i] * 2); }
                else va[h][i] = (unsigned)((h * HALF + R[i]) * RB + C[i] * 2);
            }
    }
};

typedef int i32x8 __attribute__((ext_vector_type(8)));
typedef int i32x4_t __attribute__((ext_vector_type(4)));
template <class Epi, class Sched, bool ALIGN_EPI, bool F8 = false, int SCALE_A = 127, int SCALE_B = 127>
__device__ __forceinline__ void gemm_phase(LAS unsigned char* lds, const int RB  , const Sched& S, const Epi& E) {
    const int tid = threadIdx.x, wid = __builtin_amdgcn_readfirstlane(tid >> 6), lane = tid & 63, wr = wid >> 2, wc = wid & 3, fr = lane & 15, fq = lane >> 4;
    const int nt = RB / (BK * 2);
    int Rp[2], Cp[2]; unsigned voffB[2];
#pragma unroll
    for (int i = 0; i < 2; ++i) { stage_rc(tid * 16 + i * 8192, Rp[i], Cp[i]);
        const int Rb = Epi::ADJ ? (64 * (Rp[i] >> 5) + perm32(Rp[i] & 31)) : Epi::PERM ? ((Rp[i] & ~31) + perm32(Rp[i] & 31)) : Rp[i];
        voffB[i] = (unsigned)(Rb * S.b_pitch() + Cp[i] * 2); }
    const size_t kstep = (size_t)(BK * 2);
    const size_t hstepB = (size_t)(Epi::ADJ ? 32 : HALF) * S.b_pitch(), kstepB = (size_t)S.b_kstep();
    const unsigned ldsw = (unsigned)wid * 1024u;
    const int aoff = lds_byte(wr * 64 + fr, fq * 8), boff = lds_byte(wc * 32 + fr, fq * 8);
#define PG8_SA(b, h) (((b) * 2 + (h)) * HTB)
#define PG8_SB(b, h) ((4 + (b) * 2 + (h)) * HTB)
#define PG8_STAGE(bufoff, gbase, voff) do { _Pragma("unroll") for (int _i = 0; _i < 2; ++_i) \
        __builtin_amdgcn_global_load_lds((const unsigned*)((const char*)(gbase) + (voff)[_i]), (LAS unsigned*)(lds + (bufoff) + ldsw + _i * 8192), 16, 0, 0); } while (0)
#define PG8_LDA(dst, b, h) do { _Pragma("unroll") for (int m = 0; m < 4; ++m) _Pragma("unroll") for (int k = 0; k < 2; ++k) dst[m][k] = *(const LAS bf16x8*)(lds + PG8_SA(b, h) + aoff + m * 2048 + k * 1024); } while (0)
#define PG8_LDB(dst, b, h) do { _Pragma("unroll") for (int n = 0; n < 2; ++n) _Pragma("unroll") for (int k = 0; k < 2; ++k) dst[n][k] = *(const LAS bf16x8*)(lds + PG8_SB(b, h) + boff + n * 2048 + k * 1024); } while (0)
#define PG8_CAT(x) __builtin_shufflevector(__builtin_bit_cast(i32x4_t, (x)[0]), __builtin_bit_cast(i32x4_t, (x)[1]), 0, 1, 2, 3, 4, 5, 6, 7)
#define PG8_MMA(ai, bj, At, Bt) do { __builtin_amdgcn_s_setprio(1); _Pragma("unroll") for (int m = 0; m < 4; ++m) _Pragma("unroll") for (int n = 0; n < 2; ++n) { \
        if constexpr (F8) acc[ai][bj][m][n] = __builtin_amdgcn_mfma_scale_f32_16x16x128_f8f6f4(PG8_CAT(Bt[n]), PG8_CAT(At[m]), acc[ai][bj][m][n], 0, 0, 0, SCALE_B * 0x01010101, 0, SCALE_A * 0x01010101); \
        else { _Pragma("unroll") for (int k = 0; k < 2; ++k) acc[ai][bj][m][n] = __builtin_amdgcn_mfma_f32_16x16x32_bf16(Bt[n][k], At[m][k], acc[ai][bj][m][n], 0, 0, 0); } } \
        __builtin_amdgcn_s_setprio(0); } while (0)
#define PG8_WAIT_V(n) asm volatile("s_waitcnt vmcnt(" #n ")" ::: "memory")
#define PG8_WAIT_L(n) asm volatile("s_waitcnt lgkmcnt(" #n ")" ::: "memory")
#define PG8_BAR __builtin_amdgcn_s_barrier()
#define PG8_SCHED __builtin_amdgcn_sched_barrier(0)
    Unit cur, nxt; int ui = 0;
    if (!S.next(0, cur)) return;
    int eslot = 0;
    if constexpr (Epi::PREFETCH) { if (wid == 0) E.prefetch(cur, 0, lane); }
    f32x4 acc[2][2][4][2];
#pragma unroll
    for (int a = 0; a < 2; ++a)
#pragma unroll
        for (int b = 0; b < 2; ++b)
#pragma unroll
            for (int m = 0; m < 4; ++m)
#pragma unroll
                for (int n = 0; n < 2; ++n) acc[a][b][m][n] = (f32x4){0.f, 0.f, 0.f, 0.f};
    bf16x8 At[4][2], B0[2][2], B1[2][2];
    unsigned vaC[2][2];
    S.a_voff(cur, Rp, Cp, vaC);
    const char* cA = S.a_base(cur); const char* cB = S.b_base(cur);
    PG8_STAGE(PG8_SB(0, 0), cB, voffB); PG8_STAGE(PG8_SB(0, 1), cB + hstepB, voffB); PG8_STAGE(PG8_SA(0, 0), cA, vaC[0]); PG8_STAGE(PG8_SA(0, 1), cA, vaC[1]);
    if (wr == 1) PG8_BAR;
    PG8_WAIT_V(2); PG8_BAR;
    PG8_STAGE(PG8_SB(1, 0), cB + kstepB, voffB); PG8_STAGE(PG8_SA(1, 0), cA + kstep, vaC[0]); PG8_STAGE(PG8_SB(1, 1), cB + hstepB + kstepB, voffB);
    PG8_WAIT_V(6); PG8_BAR;
    for (;;) {
        const bool has_next = S.next(ui + 1, nxt);
        const int nslot = eslot == 2 ? 0 : eslot + 1;
        if constexpr (Epi::PREFETCH) { if (has_next && wid == 0) E.prefetch(nxt, nslot, lane); }
        const char* nA = has_next ? S.a_base(nxt) : cA; const char* nB = has_next ? S.b_base(nxt) : cB;
        for (int t = 0; t < nt; t += 2) {
            const bool last = (t == nt - 2);
            const char* a1 = cA + (size_t)(t + 1) * kstep;
            const char* a2 = last ? nA : cA + (size_t)(t + 2) * kstep; const char* b2 = last ? nB : cB + (size_t)(t + 2) * kstepB;
            const char* a3 = a2 + kstep; const char* b3 = b2 + kstepB;
            PG8_LDB(B0, 0, 0); PG8_LDB(B1, 0, 1); PG8_SCHED; PG8_LDA(At, 0, 0); PG8_STAGE(PG8_SA(1, 1), a1, vaC[1]);
            if constexpr (Sched::VARA) { if (last && has_next) {
                int tl = threadIdx.x; asm volatile("" : "+v"(tl));
                int Rn[2], Cn[2];
#pragma unroll
                for (int i = 0; i < 2; ++i) stage_rc(tl * 16 + i * 8192, Rn[i], Cn[i]);
                if constexpr (Epi::PREFETCH) S.a_voff_slot(nxt, Rn, Cn, vaC, E.epi + nslot * 4096); else S.a_voff(nxt, Rn, Cn, vaC); } }
            PG8_WAIT_V(8); PG8_WAIT_L(0); PG8_BAR; PG8_MMA(0, 0, At, B0); PG8_MMA(0, 1, At, B1); PG8_BAR; PG8_SCHED;
            PG8_LDA(At, 0, 1); PG8_STAGE(PG8_SB(0, 0), b2, voffB); PG8_STAGE(PG8_SB(0, 1), b2 + hstepB, voffB); PG8_STAGE(PG8_SA(0, 0), a2, vaC[0]);
            PG8_WAIT_V(8); PG8_WAIT_L(0); PG8_BAR; PG8_MMA(1, 0, At, B0); PG8_MMA(1, 1, At, B1); PG8_BAR; PG8_SCHED;
            PG8_LDB(B0, 1, 0); PG8_LDB(B1, 1, 1); PG8_SCHED; PG8_LDA(At, 1, 0); PG8_STAGE(PG8_SA(0, 1), a2, vaC[1]);
            PG8_WAIT_V(8); PG8_WAIT_L(0); PG8_BAR; PG8_MMA(0, 0, At, B0); PG8_MMA(0, 1, At, B1); PG8_BAR; PG8_SCHED;
            PG8_LDA(At, 1, 1); PG8_STAGE(PG8_SB(1, 0), b3, voffB); PG8_STAGE(PG8_SB(1, 1), b3 + hstepB, voffB); PG8_STAGE(PG8_SA(1, 0), a3, vaC[0]);
            PG8_WAIT_V(8); PG8_WAIT_L(0); PG8_BAR; PG8_MMA(1, 0, At, B0); PG8_MMA(1, 1, At, B1); PG8_BAR; PG8_SCHED;
        }
        if constexpr (ALIGN_EPI) { if (wr == 0) PG8_BAR; }
        { int tl = threadIdx.x; asm volatile("" : "+v"(tl));
          if constexpr (Epi::PREFETCH) E(acc, cur, wr, wc, tl & 15, (tl & 63) >> 4, eslot); else E(acc, cur, wr, wc, tl & 15, (tl & 63) >> 4); }
        if (!has_next) break;
#pragma unroll
        for (int a = 0; a < 2; ++a)
#pragma unroll
            for (int b = 0; b < 2; ++b)
#pragma unroll
                for (int m = 0; m < 4; ++m)
#pragma unroll
                    for (int n = 0; n < 2; ++n) acc[a][b][m][n] = (f32x4){0.f, 0.f, 0.f, 0.f};
        cur = nxt; cA = nA; cB = nB; ++ui; eslot = nslot;
        if constexpr (ALIGN_EPI) { if (wr == 1) PG8_BAR; }
    }
    PG8_WAIT_V(0);
    if constexpr (!ALIGN_EPI) { if (wr == 0) PG8_BAR; }
    PG8_BAR;
#undef PG8_SA
#undef PG8_SB
#undef PG8_STAGE
#undef PG8_LDA
#undef PG8_LDB
#undef PG8_MMA
#undef PG8_CAT
#undef PG8_WAIT_V
#undef PG8_WAIT_L
#undef PG8_BAR
#undef PG8_SCHED
}

struct EpiQKV {
    static constexpr bool PERM = true, ADJ = false, PREFETCH = false;
    bf16_t* O; const LAS float* gtab; LAS float* P;
    __device__ __forceinline__ void operator()(f32x4 (&acc)[2][2][4][2], const Unit& u, int wr, int wc, int fr, int fq) const {
        const int pn = u.pn; const bool norm = (pn < 8) || (pn >= 12 && pn < 20);
        const LAS float* g = gtab + (pn < 4 ? 0 : pn < 8 ? 128 : pn < 16 ? 256 : 384);
        bf16_t* base = O + (size_t)(u.pm * BM + wr * 64 + fr) * INW + pn * BM + wc * 32 + 8 * fq;
        if (norm) {
#pragma unroll
            for (int ai = 0; ai < 2; ++ai)
#pragma unroll
                for (int m = 0; m < 4; ++m)
#pragma unroll
                    for (int bj = 0; bj < 2; ++bj) {
                        const f32x4 a = acc[ai][bj][m][0], b = acc[ai][bj][m][1];
                        float s = (a[0] * a[0] + a[1] * a[1]) + (a[2] * a[2] + a[3] * a[3]) + (b[0] * b[0] + b[1] * b[1]) + (b[2] * b[2] + b[3] * b[3]);
                        s += __shfl_xor(s, 16); s += __shfl_xor(s, 32);
                        if (fq == 0) P[(ai * HALF + wr * 64 + m * 16 + fr) * 8 + bj * 4 + wc] = s;
                    }
            asm volatile("s_waitcnt lgkmcnt(0)" ::: "memory"); __builtin_amdgcn_s_barrier(); asm volatile("" ::: "memory");
            const f32x4 g0 = *(const LAS f32x4*)(g + wc * 32 + 8 * fq), g1 = *(const LAS f32x4*)(g + wc * 32 + 8 * fq + 4);
#pragma unroll
            for (int ai = 0; ai < 2; ++ai)
#pragma unroll
                for (int m = 0; m < 4; ++m)
#pragma unroll
                    for (int bj = 0; bj < 2; ++bj) {
                        const f32x4 pp = *(const LAS f32x4*)(P + (ai * HALF + wr * 64 + m * 16 + fr) * 8 + bj * 4);
                        const float rstd = rsqrtf(((pp[0] + pp[1]) + (pp[2] + pp[3])) * (1.f / 128.f) + RMS_EPS);
                        const f32x4 v0 = acc[ai][bj][m][0] * rstd * g0, v1 = acc[ai][bj][m][1] * rstd * g1;
                        u32x4 w; w.x = cvt_pk_bf16(v0[0], v0[1]); w.y = cvt_pk_bf16(v0[2], v0[3]); w.z = cvt_pk_bf16(v1[0], v1[1]); w.w = cvt_pk_bf16(v1[2], v1[3]);
                        *(u32x4*)(base + (size_t)(ai * HALF + m * 16) * INW + bj * HALF) = w;
                        asm volatile("" ::: "memory");
                    }
        } else {
#pragma unroll
            for (int ai = 0; ai < 2; ++ai)
#pragma unroll
                for (int m = 0; m < 4; ++m)
#pragma unroll
                    for (int bj = 0; bj < 2; ++bj) {
                        const f32x4 v0 = acc[ai][bj][m][0], v1 = acc[ai][bj][m][1];
                        u32x4 w; w.x = cvt_pk_bf16(v0[0], v0[1]); w.y = cvt_pk_bf16(v0[2], v0[3]); w.z = cvt_pk_bf16(v1[0], v1[1]); w.w = cvt_pk_bf16(v1[2], v1[3]);
                        *(u32x4*)(base + (size_t)(ai * HALF + m * 16) * INW + bj * HALF) = w;
                    }
        }
    }
};
struct EpiResid {
    static constexpr bool PERM = false, ADJ = false, PREFETCH = false;
    const float* x; const float* gate;   float* out;
    __device__ __forceinline__ void operator()(f32x4 (&acc)[2][2][4][2], const Unit& u, int wr, int wc, int fr, int fq) const {
        const int col0 = u.pn * BM + wc * 32 + 4 * fq; const int b = (u.pm * BM) >> 11;
        f32x4 gv[2][2];
#pragma unroll
        for (int bj = 0; bj < 2; ++bj)
#pragma unroll
            for (int n = 0; n < 2; ++n) gv[bj][n] = *(const f32x4*)(gate + b * 12288 + col0 + bj * HALF + n * 16);
#pragma unroll
        for (int ai = 0; ai < 2; ++ai) {
            f32x4 xv[4][2][2];
#pragma unroll
            for (int m = 0; m < 4; ++m) { const size_t off = (size_t)(u.pm * BM + ai * HALF + wr * 64 + m * 16 + fr) * D + col0;
#pragma unroll
                for (int bj = 0; bj < 2; ++bj)
#pragma unroll
                    for (int n = 0; n < 2; ++n) xv[m][bj][n] = __builtin_nontemporal_load((const f32x4*)(x + off + bj * HALF + n * 16)); }
            asm volatile("" ::: "memory");
#pragma unroll
            for (int m = 0; m < 4; ++m) { const size_t off = (size_t)(u.pm * BM + ai * HALF + wr * 64 + m * 16 + fr) * D + col0;
#pragma unroll
                for (int bj = 0; bj < 2; ++bj)
#pragma unroll
                    for (int n = 0; n < 2; ++n) *(f32x4*)(out + off + bj * HALF + n * 16) = xv[m][bj][n] + gv[bj][n] * acc[ai][bj][m][n]; }
            asm volatile("" ::: "memory");
        }
    }
};
struct EpiSwiglu {
    static constexpr bool PERM = true, ADJ = false, PREFETCH = true;
    const float* bgu; unsigned char* act; LAS unsigned char* epi; const int* list; const LAS int* base;
    __device__ __forceinline__ void prefetch(const Unit& u, int slot, int lane) const {
        const float* src = bgu + (size_t)u.e * 4096 + u.pn * HALF + (lane < 32 ? lane * 4 : 2048 + (lane - 32) * 4);
        __builtin_amdgcn_global_load_lds((const unsigned*)src, (LAS unsigned*)(epi + slot * 4096), 16, 0, 0);
        const char* le = (const char*)list + ((size_t)u.e * 16384 + (size_t)(u.pm * BM - base[u.e])) * 8 + lane * 16;
        __builtin_amdgcn_global_load_lds((const unsigned*)le, (LAS unsigned*)(epi + slot * 4096 + 1024), 16, 0, 0);
        __builtin_amdgcn_global_load_lds((const unsigned*)(le + 1024), (LAS unsigned*)(epi + slot * 4096 + 2048), 16, 0, 0);
    }
    __device__ __forceinline__ void operator()(f32x4 (&acc)[2][2][4][2], const Unit& u, int wr, int wc, int fr, int fq, int slot) const {
        const int col0 = u.pn * HALF + wc * 32 + 8 * fq;
        const LAS float* bs = (const LAS float*)(epi + slot * 4096) + wc * 32 + 8 * fq;
        f32x4 bg[2], bu[2];
#pragma unroll
        for (int n = 0; n < 2; ++n) { bg[n] = *(const LAS f32x4*)(bs + 4 * n); bu[n] = *(const LAS f32x4*)(bs + 128 + 4 * n); }
#pragma unroll
        for (int ai = 0; ai < 2; ++ai)
#pragma unroll
            for (int m = 0; m < 4; ++m) {
                f32x4 o[2];
#pragma unroll
                for (int n = 0; n < 2; ++n) {
                    const f32x4 gg = acc[ai][0][m][n] + bg[n], uu = acc[ai][1][m][n] + bu[n];
                    f32x4 g, uc, e, r;
#pragma unroll
                    for (int j = 0; j < 4; ++j) { g[j] = fminf(gg[j], 7.f); uc[j] = fminf(fmaxf(uu[j], -7.f), 7.f); }
                    const f32x4 sg = g * (-1.702f * 1.4426950408889634f);
#pragma unroll
                    for (int j = 0; j < 4; ++j) e[j] = __builtin_amdgcn_exp2f(sg[j]);
                    const f32x4 den = e + 1.f;
#pragma unroll
                    for (int j = 0; j < 4; ++j) r[j] = __builtin_amdgcn_rcpf(den[j]);
                    o[n] = ((uc + 1.f) * g) * r; }
                u32x2 w; w.x = pk4_fp8(o[0][0], o[0][1], o[0][2], o[0][3]); w.y = pk4_fp8(o[1][0], o[1][1], o[1][2], o[1][3]);
                *(u32x2*)(act + (size_t)(u.pm * BM + ai * HALF + wr * 64 + m * 16 + fr) * DFF + col0) = w;
            }
    }
};
struct EpiDown {
    static constexpr bool PERM = true, ADJ = true, PREFETCH = true;
    const float* bdn; unsigned char* Y; const LAS int* base; const LAS int* cnt; const int* list; LAS unsigned char* epi;
    __device__ __forceinline__ void prefetch(const Unit& u, int slot, int lane) const {
        LAS unsigned char* s = epi + slot * 4096;
        __builtin_amdgcn_global_load_lds((const unsigned*)(bdn + (size_t)u.e * D + u.pn * BM + lane * 4), (LAS unsigned*)s, 16, 0, 0);
        const char* le = (const char*)list + ((size_t)u.e * 16384 + (size_t)(u.pm * BM - base[u.e])) * 8 + lane * 16;
        __builtin_amdgcn_global_load_lds((const unsigned*)le, (LAS unsigned*)(s + 1024), 16, 0, 0);
        __builtin_amdgcn_global_load_lds((const unsigned*)(le + 1024), (LAS unsigned*)(s + 2048), 16, 0, 0);
    }
    __device__ __forceinline__ void operator()(f32x4 (&acc)[2][2][4][2], const Unit& u, int wr, int wc, int fr, int fq, int slot) const {
        const int col0 = u.pn * BM + wc * 64 + 8 * fq;
        const LAS unsigned char* s = epi + slot * 4096;
        const LAS float* bs = (const LAS float*)s + wc * 64 + 8 * fq;
        f32x4 bv[2][2];
#pragma unroll
        for (int bj = 0; bj < 2; ++bj)
#pragma unroll
            for (int n = 0; n < 2; ++n) bv[bj][n] = *(const LAS f32x4*)(bs + bj * 32 + 4 * n);
        const int row0 = wr * 64 + fr; const int nvalid = cnt[u.e] - (u.pm * BM - base[u.e]);
        const LAS u32x2* le = (const LAS u32x2*)(s + 1024);
#pragma unroll
        for (int ai = 0; ai < 2; ++ai)
#pragma unroll
            for (int m = 0; m < 4; ++m) { const int rl = row0 + ai * HALF + m * 16;
                if (rl < nvalid) { const u32x2 ent = le[rl]; const int code = (int)ent.x; const float g = __uint_as_float(ent.y) * (float)(1 << YSH);
#pragma unroll
                    for (int bj = 0; bj < 2; ++bj) { const f32x4 v0 = (acc[ai][bj][m][0] + bv[bj][0]) * g, v1 = (acc[ai][bj][m][1] + bv[bj][1]) * g;
                        u32x2 w; w.x = pk4_fp8(v0[0], v0[1], v0[2], v0[3]); w.y = pk4_fp8(v1[0], v1[1], v1[2], v1[3]);
                        *(u32x2*)(Y + (size_t)code * D + col0 + bj * 32) = w; } } }
    }
};
}
namespace att {
constexpr int NW = 8, QBLK = 32, KVBLK = 64, LDQ = INW;
constexpr float SCALE = 0.088388347648318440f;
constexpr float ISCALE = 11.313708498984761f;
constexpr float THR = 8.f;
constexpr float NEGBIG = -1.0e30f;
constexpr int SHM_V = KVBLK * 128 * 2, SHM_K = KVBLK * 128 * 2;
constexpr int T5N = 447, T5C = 223;
constexpr int KSTG = 3, VSTG = 4;
constexpr int OFF_K = 0, OFF_V = KSTG * SHM_K, OFF_WS = OFF_V + VSTG * SHM_V, OFF_T5 = OFF_WS + NW * 64 * 4, OFF_RPB = OFF_T5 + 4 * T5N * 4;
constexpr int OFF_RPB_A = ((OFF_RPB + 15) & ~15) + 256, ATT_LDS_END = OFF_RPB_A + 8 * 465 * 4 + 256;
static_assert(ATT_LDS_END <= LDSCTL_OFF, "attention LDS (the exchange / gain areas above the ring are free during the attention phase)");
#define KSWZ(row, colB) ((row) * 256 + ((colB) ^ (((row) & 7) << 4)))
#define SBAR() __builtin_amdgcn_sched_barrier(0)
__device__ __forceinline__ int crow(int r, int hi) { return (r & 3) + 8 * (r >> 2) + 4 * hi; }

struct TileCtx {
    int mode;
    const LAS float* tab;
    int qw0;
    int r0, c0, kb16, rs_u;
};
__device__ __forceinline__ float tile_bias(f32x16& p0, f32x16& p1, const TileCtx& c, int t, int hi, int r32) {
    const int k0 = t * KVBLK;
    if (k0 - (c.qw0 + 31) >= 128) return c.tab[T5C + 128];
    if (k0 + 63 - c.qw0 <= -128) return c.tab[T5C - 128];
    int z = 0; asm volatile("" : "+v"(z));
    const LAS float* tb = c.tab + (T5C + k0 - c.qw0) + (4 * hi - r32 + z);
#pragma unroll
    for (int g = 0; g < 4; ++g) {
#pragma unroll
        for (int rr = 0; rr < 4; ++rr) { const int r = g * 4 + rr; p0[r] += tb[rr + 8 * g]; p1[r] += tb[rr + 8 * g + 32]; }
        asm volatile("" ::: "memory");
    }
    return 0.f;
}
__device__ __forceinline__ void tile_bias_nat(f32x16& p0, const TileCtx& c, int t, int hi, int r32) {
    int z = 0; asm volatile("" : "+v"(z));
    const int q = r32 + z, grow = c.r0 + (q >> 3), gcol = c.c0 + (q & 7), krow = c.rs_u + t;
    const bool inband = (unsigned)(krow - min(max(grow - 4, 0), 24)) < 8u;
    const int ro = min(max(krow - grow + 7, 0), 14), cs = min(max(gcol - 8, 0), 48);
    const int t0 = c.kb16 + 4 * hi - cs;
    const LAS float* tb = c.tab + ro * 31 + 15 - gcol + c.kb16 + 4 * hi;
#pragma unroll
    for (int g = 0; g < 4; ++g) {
#pragma unroll
        for (int rr = 0; rr < 4; ++rr) { const int r = g * 4 + rr, kr = rr + 8 * g;
            const bool in0 = inband && (unsigned)(t0 + kr) < 16u; const float b0 = tb[kr];
            p0[r] = in0 ? p0[r] + b0 : NEGBIG; }
        asm volatile("" ::: "memory");
    }
}
__device__ __forceinline__ void partialSM(f32x16& p0, f32x16& p1, float cb, float& m_reg, float& mn, float& alpha) {
    constexpr float C = SCALE * 1.4426950408889634f;
    float pmax = p0[0];
#pragma unroll
    for (int r = 1; r < 16; ++r) pmax = fmaxf(pmax, p0[r]);
#pragma unroll
    for (int r = 0; r < 16; ++r) pmax = fmaxf(pmax, p1[r]);
    { auto rr = __builtin_amdgcn_permlane32_swap(__float_as_uint(pmax), __float_as_uint(pmax), false, false);
      pmax = fmaxf(__uint_as_float(rr[0]), __uint_as_float(rr[1])); }
    pmax += cb;
    if (__builtin_expect(__all(pmax - m_reg <= THR / SCALE), 1)) { mn = m_reg; alpha = 1.f; }
    else { mn = fmaxf(m_reg, pmax); alpha = __builtin_amdgcn_exp2f((m_reg - mn) * C); m_reg = mn; }
    const float mnC = (cb - mn) * C;
#pragma unroll
    for (int r = 0; r < 16; ++r) p0[r] = fmaf(p0[r], C, mnC);
#pragma unroll
    for (int r = 0; r < 16; ++r) p1[r] = fmaf(p1[r], C, mnC);
#pragma unroll
    for (int r = 0; r < 16; ++r) p0[r] = __builtin_amdgcn_exp2f(p0[r]);
}
__device__ __forceinline__ void finishSM(f32x16& p0, f32x16& p1, float alpha, float& l_reg, bf16x8& pa0, bf16x8& pa1, bf16x8& pa2, bf16x8& pa3) {
#pragma unroll
    for (int r = 0; r < 16; ++r) p1[r] = __builtin_amdgcn_exp2f(p1[r]);
    float ps = 0;
#pragma unroll
    for (int r = 0; r < 16; ++r) ps += p0[r];
#pragma unroll
    for (int r = 0; r < 16; ++r) ps += p1[r];
    { auto rr = __builtin_amdgcn_permlane32_swap(__float_as_uint(ps), __float_as_uint(ps), false, false);
      ps = __uint_as_float(rr[0]) + __uint_as_float(rr[1]); }
    l_reg = l_reg * alpha + ps;
#define PK4(P, BASE, OUT) do { unsigned a0 = cvt_pk_bf16(P[BASE + 0], P[BASE + 1]), a1 = cvt_pk_bf16(P[BASE + 2], P[BASE + 3]);   \
    unsigned b0 = cvt_pk_bf16(P[BASE + 4], P[BASE + 5]), b1 = cvt_pk_bf16(P[BASE + 6], P[BASE + 7]);                              \
    auto r0 = __builtin_amdgcn_permlane32_swap(a0, b0, false, false); auto r1 = __builtin_amdgcn_permlane32_swap(a1, b1, false, false); \
    u32x4 w = {r0[0], r1[0], r0[1], r1[1]}; OUT = *reinterpret_cast<bf16x8*>(&w); } while (0)
    PK4(p0, 0, pa0); PK4(p0, 8, pa1); PK4(p1, 0, pa2); PK4(p1, 8, pa3);
#undef PK4
}
__device__ __forceinline__ void qkt(f32x16& p0, f32x16& p1, const LAS char* Ks, const bf16x8* qr, int r32, int hi) {
    p0 = f32x16{}; p1 = f32x16{};
#pragma unroll
    for (int d0 = 0; d0 < 8; ++d0) { const int cb = (d0 * 16 + hi * 8) * 2;
        const bf16x8 b0 = *reinterpret_cast<const LAS bf16x8*>(Ks + KSWZ(r32, cb));
        const bf16x8 b1 = *reinterpret_cast<const LAS bf16x8*>(Ks + KSWZ(32 + r32, cb));
        p0 = __builtin_amdgcn_mfma_f32_32x32x16_bf16(b0, qr[d0], p0, 0, 0, 0);
        p1 = __builtin_amdgcn_mfma_f32_32x32x16_bf16(b1, qr[d0], p1, 0, 0, 0); }
}
__device__ __forceinline__ int v_st(int k, int c) { const int kk = (k & ~0xC) | ((k & 4) << 1) | ((k & 8) >> 1); return ((kk >> 3) * 4 + (c >> 5)) * 512 + ((kk & 7) * 32 + (c & 31)) * 2; }
__device__ __forceinline__ int v_rd_base(int lane) { return ((lane & 3) << 3) | (((lane >> 2) & 3) << 6) | (((lane >> 4) & 1) << 5) | (((lane >> 5) & 1) << 8); }
constexpr int v_rd_off(int d0, int ks, int half) { return d0 * 512 + ks * 4096 + half * 2048; }
template <int OFF> __device__ __forceinline__ s16x4 tr_read(int vb) {
    s16x4 r; asm volatile("ds_read_b64_tr_b16 %0, %1 offset:%2" : "=&v"(r) : "v"(vb), "i"(OFF) : "memory"); return r;
}
template <int D0> __device__ __forceinline__ void pv_one(f32x16& od, int vb, bf16x8 pa0, bf16x8 pa1, bf16x8 pa2, bf16x8 pa3) {
    const s16x4 l0 = tr_read<v_rd_off(D0, 0, 0)>(vb), h0 = tr_read<v_rd_off(D0, 0, 1)>(vb), l1 = tr_read<v_rd_off(D0, 1, 0)>(vb), h1 = tr_read<v_rd_off(D0, 1, 1)>(vb);
    const s16x4 l2 = tr_read<v_rd_off(D0, 2, 0)>(vb), h2 = tr_read<v_rd_off(D0, 2, 1)>(vb), l3 = tr_read<v_rd_off(D0, 3, 0)>(vb), h3 = tr_read<v_rd_off(D0, 3, 1)>(vb);
    asm volatile("s_waitcnt lgkmcnt(0)" ::: "memory"); SBAR();
#define PK(L, H) (bf16x8){L[0], L[1], L[2], L[3], H[0], H[1], H[2], H[3]}
    od = __builtin_amdgcn_mfma_f32_32x32x16_bf16(pa0, PK(l0, h0), od, 0, 0, 0);
    od = __builtin_amdgcn_mfma_f32_32x32x16_bf16(pa1, PK(l1, h1), od, 0, 0, 0);
    od = __builtin_amdgcn_mfma_f32_32x32x16_bf16(pa2, PK(l2, h2), od, 0, 0, 0);
    od = __builtin_amdgcn_mfma_f32_32x32x16_bf16(pa3, PK(l3, h3), od, 0, 0, 0);
#undef PK
}
__device__ __forceinline__ void pv_d0(f32x16* o, int vb, bf16x8 pa0, bf16x8 pa1, bf16x8 pa2, bf16x8 pa3) {
    pv_one<0>(o[0], vb, pa0, pa1, pa2, pa3); pv_one<1>(o[1], vb, pa0, pa1, pa2, pa3); pv_one<2>(o[2], vb, pa0, pa1, pa2, pa3); pv_one<3>(o[3], vb, pa0, pa1, pa2, pa3);
}

__device__ __forceinline__ void partialSM_h(f32x16& p0, float& m_reg, float& mn, float& alpha) {
    constexpr float C = SCALE * 1.4426950408889634f;
    float pmax = p0[0];
#pragma unroll
    for (int r = 1; r < 16; ++r) pmax = fmaxf(pmax, p0[r]);
    { auto rr = __builtin_amdgcn_permlane32_swap(__float_as_uint(pmax), __float_as_uint(pmax), false, false);
      pmax = fmaxf(__uint_as_float(rr[0]), __uint_as_float(rr[1])); }
    if (__builtin_expect(__all(pmax - m_reg <= THR / SCALE), 1)) { mn = m_reg; alpha = 1.f; }
    else { mn = fmaxf(m_reg, pmax); alpha = __builtin_amdgcn_exp2f((m_reg - mn) * C); m_reg = mn; }
    const float mnC = -mn * C;
#pragma unroll
    for (int r = 0; r < 16; ++r) p0[r] = __builtin_amdgcn_exp2f(fmaf(p0[r], C, mnC));
}
__device__ __forceinline__ void finishSM_h(f32x16& p0, float alpha, float& l_reg, bf16x8& pa0, bf16x8& pa1) {
    float ps = 0;
#pragma unroll
    for (int r = 0; r < 16; ++r) ps += p0[r];
    { auto rr = __builtin_amdgcn_permlane32_swap(__float_as_uint(ps), __float_as_uint(ps), false, false);
      ps = __uint_as_float(rr[0]) + __uint_as_float(rr[1]); }
    l_reg = l_reg * alpha + ps;
#define PK4(P, BASE, OUT) do { unsigned a0 = cvt_pk_bf16(P[BASE + 0], P[BASE + 1]), a1 = cvt_pk_bf16(P[BASE + 2], P[BASE + 3]);   \
    unsigned b0 = cvt_pk_bf16(P[BASE + 4], P[BASE + 5]), b1 = cvt_pk_bf16(P[BASE + 6], P[BASE + 7]);                              \
    auto r0 = __builtin_amdgcn_permlane32_swap(a0, b0, false, false); auto r1 = __builtin_amdgcn_permlane32_swap(a1, b1, false, false); \
    u32x4 w = {r0[0], r1[0], r0[1], r1[1]}; OUT = *reinterpret_cast<bf16x8*>(&w); } while (0)
    PK4(p0, 0, pa0); PK4(p0, 8, pa1);
#undef PK4
}
__device__ __forceinline__ void qkt_h(f32x16& p0, const LAS char* Ks, const bf16x8* qr, int r32, int hi) {
    p0 = f32x16{};
#pragma unroll
    for (int d0 = 0; d0 < 8; ++d0) { const int cb = (d0 * 16 + hi * 8) * 2;
        const bf16x8 b0 = *reinterpret_cast<const LAS bf16x8*>(Ks + KSWZ(r32, cb));
        p0 = __builtin_amdgcn_mfma_f32_32x32x16_bf16(b0, qr[d0], p0, 0, 0, 0); }
}
template <int D0> __device__ __forceinline__ void pv_one_h(f32x16& od, int vb, bf16x8 pa0, bf16x8 pa1) {
    s16x4 l0 = tr_read<v_rd_off(D0, 0, 0)>(vb), h0 = tr_read<v_rd_off(D0, 0, 1)>(vb), l1 = tr_read<v_rd_off(D0, 1, 0)>(vb), h1 = tr_read<v_rd_off(D0, 1, 1)>(vb);
    asm volatile("s_waitcnt lgkmcnt(0)" : "+v"(l0), "+v"(h0), "+v"(l1), "+v"(h1) :: "memory");
#define PK(L, H) (bf16x8){L[0], L[1], L[2], L[3], H[0], H[1], H[2], H[3]}
    od = __builtin_amdgcn_mfma_f32_32x32x16_bf16(pa0, PK(l0, h0), od, 0, 0, 0);
    od = __builtin_amdgcn_mfma_f32_32x32x16_bf16(pa1, PK(l1, h1), od, 0, 0, 0);
#undef PK
}
__device__ __forceinline__ void pv_h(f32x16* o, int vb, bf16x8 pa0, bf16x8 pa1) {
    pv_one_h<0>(o[0], vb, pa0, pa1); pv_one_h<1>(o[1], vb, pa0, pa1); pv_one_h<2>(o[2], vb, pa0, pa1); pv_one_h<3>(o[3], vb, pa0, pa1);
}

template <int MODE>
__device__ __forceinline__ void attn_pass(const bf16_t* __restrict__ Qb, const bf16_t* __restrict__ Kh, const bf16_t* __restrict__ Vh, int NT, int tbase, int tmax,
                                          const TileCtx& ctx, LAS char* lds, f32x16 (&o)[4]) {
    int tid = threadIdx.x; asm volatile("" : "+v"(tid));
    const int wid = __builtin_amdgcn_readfirstlane(tid >> 6), lane = tid & 63, r32 = lane & 31, hi = lane >> 5;
    LAS char* V_lds = lds + OFF_V; LAS char* K_lds = lds + OFF_K;
    LAS float* wsl = (LAS float*)(lds + OFF_WS) + wid * 64; LAS float* li_l = wsl; LAS float* al_l = wsl + 32;
    float m_reg = -1e30f, l_reg = 0;
#pragma unroll
    for (int d = 0; d < 4; ++d) o[d] = f32x16{};
    unsigned kso[2], vso[2];
#pragma unroll
    for (int i = 0; i < 2; ++i) { const int P = i * 8192 + tid * 16;
        { const int row = P >> 8, cbp = P & 255, cb = cbp ^ ((row & 7) << 4); kso[i] = (unsigned)(row * LDQ * 2 + cb); }
        { const int sub = P >> 9, within = P & 511, kk = (sub >> 2) * 8 + (within >> 6), c = (sub & 3) * 32 + ((within & 63) >> 1);
          const int k = (kk & ~0xC) | ((kk & 4) << 1) | ((kk & 8) >> 1); vso[i] = (unsigned)(k * LDQ * 2 + c * 2); } }
    const int vb0 = (int)(uintptr_t)V_lds + v_rd_base(lane);
    const unsigned dmaw = (unsigned)wid * 1024u;
#define KROWB(t) ((size_t)(min(tbase + (t), tmax) * KVBLK) * LDQ * 2)
#define ISSUE(t, ks, vs) do { const size_t ro_ = KROWB(t); const char* kb_ = (const char*)Kh + ro_; const char* vb_ = (const char*)Vh + ro_; \
    _Pragma("unroll") for (int i_ = 0; i_ < 2; ++i_) { \
        __builtin_amdgcn_global_load_lds((const unsigned*)(kb_ + kso[i_]), (LAS unsigned*)(K_lds + (ks) * SHM_K + i_ * 8192 + dmaw), 16, 0, 0); \
        __builtin_amdgcn_global_load_lds((const unsigned*)(vb_ + vso[i_]), (LAS unsigned*)(V_lds + (vs) * SHM_V + i_ * 8192 + dmaw), 16, 0, 0); } } while (0)
#define TOP(n) asm volatile("s_waitcnt vmcnt(" #n ") lgkmcnt(0)\n\ts_barrier" ::: "memory")
#define RESC(a) do { if (__any((a) < 1.f)) { if (hi == 0) al_l[r32] = (a); asm volatile("s_waitcnt lgkmcnt(0)" ::: "memory"); \
    _Pragma("unroll") for (int d = 0; d < 4; ++d) _Pragma("unroll") for (int r = 0; r < 16; ++r) o[d][r] *= al_l[crow(r, hi)]; } } while (0)
#define ADV3(x) ((x) == 2 ? 0 : (x) + 1)
#define ADV4(x) (((x) + 1) & 3)
    bf16x8 qr[8];
    const bf16_t* Qw = Qb + (size_t)(MODE == 0 ? wid * QBLK + r32 : (r32 >> 3) * 64 + ctx.c0 + (r32 & 7)) * LDQ + hi * 8;
    const int kboff = ctx.kb16 * 256, vkoff = (ctx.kb16 >> 4) * 4096;
#pragma unroll
    for (int d0 = 0; d0 < 8; ++d0) qr[d0] = *reinterpret_cast<const bf16x8*>(Qw + d0 * 16);
    f32x16 pA0, pA1, pB0, pB1; float mnA, mnB, alA, alB, cbA, cbB; bf16x8 pa0, pa1, pa2, pa3;
#define QKT(P0, P1) do { if constexpr (MODE == 0) qkt(P0, P1, K_lds + kq * SHM_K, qr, r32, hi); else qkt_h(P0, K_lds + kq * SHM_K + kboff, qr, r32, hi); kq = ADV3(kq); } while (0)
#define PSM(P0, P1, cb_, mn_, al_, t_) do { if constexpr (MODE == 0) { cb_ = tile_bias(P0, P1, ctx, (t_), hi, r32); partialSM(P0, P1, cb_, m_reg, mn_, al_); } \
        else { tile_bias_nat(P0, ctx, (t_), hi, r32); partialSM_h(P0, m_reg, mn_, al_); } } while (0)
#define FSM(P0, P1, al_) do { if constexpr (MODE == 0) finishSM(P0, P1, al_, l_reg, pa0, pa1, pa2, pa3); else finishSM_h(P0, al_, l_reg, pa0, pa1); } while (0)
#define PVS() do { if constexpr (MODE == 0) pv_d0(o, vb0 + vq * SHM_V, pa0, pa1, pa2, pa3); else pv_h(o, vb0 + vq * SHM_V + vkoff, pa0, pa1); vq = ADV4(vq); } while (0)
    asm volatile("s_waitcnt lgkmcnt(0)\n\ts_barrier" ::: "memory");
    ISSUE(0, 0, 0); ISSUE(1, 1, 1);
    int kq = 0, vq = 0;
    int ki = 2, vi = 2;
    TOP(4); ISSUE(2, ki, vi); ki = ADV3(ki); vi = ADV4(vi);
    QKT(pA0, pA1); PSM(pA0, pA1, cbA, mnA, alA, 0);
    for (int j = 1; j + 1 < NT; j += 2) {
        TOP(4); ISSUE(j + 2, ki, vi); ki = ADV3(ki); vi = ADV4(vi);
        SBAR(); QKT(pB0, pB1);
        FSM(pA0, pA1, alA); SBAR();
        PVS(); PSM(pB0, pB1, cbB, mnB, alB, j);
        RESC(alB);
        if (j + 3 < NT) { TOP(4); ISSUE(j + 3, ki, vi); ki = ADV3(ki); vi = ADV4(vi); } else { TOP(0); }
        SBAR(); QKT(pA0, pA1);
        FSM(pB0, pB1, alB); SBAR();
        PVS(); PSM(pA0, pA1, cbA, mnA, alA, j + 1);
        RESC(alA);
    }
    TOP(0);
    SBAR(); QKT(pB0, pB1);
    FSM(pA0, pA1, alA); SBAR();
    PVS(); PSM(pB0, pB1, cbB, mnB, alB, NT - 1);
    RESC(alB);
    FSM(pB0, pB1, alB); SBAR();
    PVS();
    if (hi == 0) li_l[r32] = l_reg; asm volatile("s_waitcnt lgkmcnt(0)" ::: "memory");
#pragma unroll
    for (int r = 0; r < 16; ++r) { const float rl = __builtin_amdgcn_rcpf(li_l[crow(r, hi)]);
#pragma unroll
        for (int d = 0; d < 4; ++d) o[d][r] *= rl; }
#undef KROWB
#undef ISSUE
#undef TOP
#undef RESC
#undef ADV3
#undef ADV4
#undef QKT
#undef PSM
#undef FSM
#undef PVS
}

__device__ __forceinline__ float tile_bias_hw(f32x16& p0, const TileCtx& c, int t, int hf, int hi, int r32) {
    const int k0 = t * KVBLK + hf * 32;
    if (k0 - (c.qw0 + 31) >= 128) return c.tab[T5C + 128];
    if (k0 + 31 - c.qw0 <= -128) return c.tab[T5C - 128];
    int z = 0; asm volatile("" : "+v"(z));
    const LAS float* tb = c.tab + (T5C + k0 - c.qw0) + (4 * hi - r32 + z);
#pragma unroll
    for (int g = 0; g < 4; ++g) {
#pragma unroll
        for (int rr = 0; rr < 4; ++rr) { const int r = g * 4 + rr; p0[r] += tb[rr + 8 * g]; }
        asm volatile("" ::: "memory");
    }
    return 0.f;
}
__device__ __forceinline__ void partialSM_hc(f32x16& p0, float cb, float& m_reg, float& mn, float& alpha) {
    constexpr float C = SCALE * 1.4426950408889634f;
    float pmax = p0[0];
#pragma unroll
    for (int r = 1; r < 16; ++r) pmax = fmaxf(pmax, p0[r]);
    { auto rr = __builtin_amdgcn_permlane32_swap(__float_as_uint(pmax), __float_as_uint(pmax), false, false);
      pmax = fmaxf(__uint_as_float(rr[0]), __uint_as_float(rr[1])); }
    pmax += cb;
    if (__builtin_expect(__all(pmax - m_reg <= THR / SCALE), 1)) { mn = m_reg; alpha = 1.f; }
    else { mn = fmaxf(m_reg, pmax); alpha = __builtin_amdgcn_exp2f((m_reg - mn) * C); m_reg = mn; }
    const float mnC = (cb - mn) * C;
#pragma unroll
    for (int r = 0; r < 16; ++r) p0[r] = __builtin_amdgcn_exp2f(fmaf(p0[r], C, mnC));
}
__device__ __forceinline__ void attn_pass_w(const bf16_t* __restrict__ Qb, const bf16_t* __restrict__ Kh, const bf16_t* __restrict__ Vh, int NT, const TileCtx& ctx, LAS char* lds, f32x16 (&o)[8], float (&rl)[16]) {
    int tid = threadIdx.x; asm volatile("" : "+v"(tid));
    const int wid = __builtin_amdgcn_readfirstlane(tid >> 6), lane = tid & 63, r32 = lane & 31, hi = lane >> 5;
    LAS char* K_lds = lds; LAS char* V_lds = lds + 32768;
    LAS float* wsl = (LAS float*)(lds + OFF_WS) + wid * 64; LAS float* li_l = wsl; LAS float* al_l = wsl + 32;
    float m_reg = -1e30f, l_reg = 0;
#pragma unroll
    for (int d = 0; d < 8; ++d) o[d] = f32x16{};
    unsigned kso[2], vso[2];
#pragma unroll
    for (int i = 0; i < 2; ++i) { const int P = i * 8192 + tid * 16;
        { const int row = P >> 8, cbp = P & 255, cb = cbp ^ ((row & 7) << 4); kso[i] = (unsigned)(row * LDQ * 2 + cb); }
        { const int sub = P >> 9, within = P & 511, kk = (sub >> 2) * 8 + (within >> 6), c = (sub & 3) * 32 + ((within & 63) >> 1);
          const int k = (kk & ~0xC) | ((kk & 4) << 1) | ((kk & 8) >> 1); vso[i] = (unsigned)(k * LDQ * 2 + c * 2); } }
    const int vb0 = (int)(uintptr_t)V_lds + v_rd_base(lane);
    const unsigned dmaw = (unsigned)wid * 1024u;
#define ISSUEW(t, st) do { const size_t ro_ = (size_t)((t) * KVBLK) * LDQ * 2; const char* kb_ = (const char*)Kh + ro_; const char* vb_ = (const char*)Vh + ro_; \
    _Pragma("unroll") for (int i_ = 0; i_ < 2; ++i_) { \
        __builtin_amdgcn_global_load_lds((const unsigned*)(kb_ + kso[i_]), (LAS unsigned*)(K_lds + (st) * 16384 + i_ * 8192 + dmaw), 16, 0, 0); \
        __builtin_amdgcn_global_load_lds((const unsigned*)(vb_ + vso[i_]), (LAS unsigned*)(V_lds + (st) * 32768 + i_ * 8192 + dmaw), 16, 0, 0); \
        __builtin_amdgcn_global_load_lds((const unsigned*)(vb_ + 256 + vso[i_]), (LAS unsigned*)(V_lds + (st) * 32768 + 16384 + i_ * 8192 + dmaw), 16, 0, 0); } } while (0)
    bf16x8 qr[8];
    const bf16_t* Qw = Qb + (size_t)(wid * QBLK + r32) * LDQ + hi * 8;
#pragma unroll
    for (int d0 = 0; d0 < 8; ++d0) qr[d0] = *reinterpret_cast<const bf16x8*>(Qw + d0 * 16);
    asm volatile("s_waitcnt lgkmcnt(0)\n\ts_barrier" ::: "memory");
    ISSUEW(0, 0);
#pragma unroll 1
    for (int t = 0; t < NT; ++t) {
        asm volatile("s_waitcnt vmcnt(0) lgkmcnt(0)\n\ts_barrier" ::: "memory");
        const int st = t & 1;
        f32x16 pq[2];
        qkt(pq[0], pq[1], K_lds + st * 16384, qr, r32, hi);
        if (t + 1 < NT) ISSUEW(t + 1, st ^ 1);
        float mn0, al0, mn1, al1; bf16x8 pa00, pa01, pa10, pa11;
        const float cb0 = tile_bias_hw(pq[0], ctx, t, 0, hi, r32);
        const float cb1 = tile_bias_hw(pq[1], ctx, t, 1, hi, r32);
        partialSM_hc(pq[0], cb0, m_reg, mn0, al0);
        finishSM_h(pq[0], al0, l_reg, pa00, pa01);
#define RESC8(al_) do { if (__any((al_) < 1.f)) { if (hi == 0) al_l[r32] = (al_); asm volatile("s_waitcnt lgkmcnt(0)" ::: "memory"); \
            _Pragma("unroll") for (int r = 0; r < 16; ++r) { const float a = al_l[crow(r, hi)]; _Pragma("unroll") for (int d = 0; d < 8; ++d) o[d][r] *= a; } } } while (0)
        RESC8(al0);
        pv_h(o, vb0 + st * 32768, pa00, pa01);
        pv_h(o + 4, vb0 + st * 32768 + 16384, pa00, pa01);
        partialSM_hc(pq[1], cb1, m_reg, mn1, al1);
        finishSM_h(pq[1], al1, l_reg, pa10, pa11);
        RESC8(al1);
        pv_h(o, vb0 + st * 32768 + 8192, pa10, pa11);
        pv_h(o + 4, vb0 + st * 32768 + 16384 + 8192, pa10, pa11);
#undef RESC8
    }
    if (hi == 0) li_l[r32] = l_reg; asm volatile("s_waitcnt lgkmcnt(0)" ::: "memory");
#pragma unroll
    for (int r = 0; r < 16; ++r) rl[r] = __builtin_amdgcn_rcpf(li_l[crow(r, hi)]);
#undef ISSUEW
}
}
struct Args { const float* in[22]; float* out; unsigned char* ws; int ph_lo, ph_hi, flags, pad; };
constexpr int NPHASE = 9;

__device__ __forceinline__ int t5_bucket(int rel) {
    const int ret = rel > 0 ? 16 : 0; const int n = rel < 0 ? -rel : rel;
    int v;
    if (n < 8) v = n; else if (n < 12) v = 8; else if (n < 16) v = 9; else if (n < 23) v = 10; else if (n < 32) v = 11; else if (n < 46) v = 12; else if (n < 64) v = 13; else if (n < 91) v = 14; else v = 15;
    return ret + v;
}

template <bool F8, bool GUPERM>
__device__ __forceinline__ void transpose_range(const float* __restrict__ W, int K, int N, unsigned char* __restrict__ WT, int rlo, int rhi, float scale, int gw, int NGW, LAS float* scr, int lane, int dbg = 0) {
    const int nblk = N / 32, ipe = (K / 64) * nblk, nitems = rhi;
    const int lr = lane >> 3, lc = (lane & 7) * 4;
    const unsigned loff = (unsigned)(lr * N + lc) * 4u;
    f32x4 v0[8], v1[8], v2[8], v3[8];
    const int npw = (nitems - (rlo + 2 * gw) + 2 * NGW - 1) / (2 * NGW);
    if (nitems - (rlo + 2 * gw) <= 0) return;
    const int rlast = rlo + 2 * gw + (npw - 1) * 2 * NGW;
    int r0 = rlo + 2 * gw, r2 = r0 + 2 * NGW;
#define TR_KB(rr_) (2 * ((rr_) / (2 * nblk)) + ((rr_) & 1))
#define TR_NB(rr_) (((rr_) % (2 * nblk)) >> 1)
#define TR_LOAD(v_, r_) do { const int ru_ = __builtin_amdgcn_readfirstlane(min((r_), rlast + ((r_) & 1))); const int e_ = ru_ / ipe, rr_ = ru_ % ipe; \
        const char* ub_ = (const char*)W + ((size_t)e_ * K * N + (size_t)(TR_KB(rr_) * 64) * N + TR_NB(rr_) * 32) * 4;     \
        _Pragma("unroll") for (int i_ = 0; i_ < 8; ++i_) asm volatile("global_load_dwordx4 %0, %1, %2 nt" : "=v"(v_[i_]) : "v"(loff), "s"(ub_ + (size_t)(8 * i_) * N * 4) : "memory"); } while (0)
#define TR_WAIT() do { if (more_) asm volatile("s_waitcnt vmcnt(24)" ::: "memory"); else asm volatile("s_waitcnt vmcnt(0)" ::: "memory"); } while (0)
#define TR_WRITE(v_, sc_) do { _Pragma("unroll") for (int i_ = 0; i_ < 8; ++i_) { LAS float* d_ = (sc_) + (8 * i_ + lr) * 33 + lc; d_[0] = v_[i_][0]; d_[1] = v_[i_][1]; d_[2] = v_[i_][2]; d_[3] = v_[i_][3]; } } while (0)
#define TR_P4(b_) pk4_fp8(s[(b_) * 33] * scale, s[((b_) + 1) * 33] * scale, s[((b_) + 2) * 33] * scale, s[((b_) + 3) * 33] * scale)
#define TR_EMIT2(rc_, s0_, s1_) do { \
        const int e_ = (rc_) / ipe, rr_ = (rc_) % ipe, k0_ = TR_KB(rr_) * 64, n0_ = TR_NB(rr_) * 32; \
        const int drow0_ = GUPERM ? ((n0_ & 2047) >> 7) * 256 + (n0_ >> 11) * 128 + (n0_ & 127) : n0_; \
        if constexpr (F8) { const int n = lane >> 1, h = lane & 1; const LAS float* s = (h ? (s1_) : (s0_)) + n; u32x4 o0, o1, o2, o3; \
            o0.x = TR_P4(0); o0.y = TR_P4(4); o0.z = TR_P4(8); o0.w = TR_P4(12); o1.x = TR_P4(16); o1.y = TR_P4(20); o1.z = TR_P4(24); o1.w = TR_P4(28); \
            o2.x = TR_P4(32); o2.y = TR_P4(36); o2.z = TR_P4(40); o2.w = TR_P4(44); o3.x = TR_P4(48); o3.y = TR_P4(52); o3.z = TR_P4(56); o3.w = TR_P4(60); \
            unsigned char* dst = WT + ((((size_t)e_ * (N / 256) + (drow0_ >> 8)) * (K / 128) + (k0_ >> 7)) << 15) + ((drow0_ & 255) + n) * 128 + 64 * h;     \
            if (!(dbg & 2)) { *(u32x4*)dst = o0; *(u32x4*)(dst + 16) = o1; *(u32x4*)(dst + 32) = o2; *(u32x4*)(dst + 48) = o3; } } \
        else { const int c8 = lane & 7; \
            _Pragma("unroll") for (int hh = 0; hh < 2; ++hh) _Pragma("unroll") for (int jj = 0; jj < 4; ++jj) { const int n = (lane >> 3) + 8 * jj; const LAS float* s = (hh ? (s1_) : (s0_)) + (8 * c8) * 33 + n; \
                u32x4 o; o.x = cvt_pk_bf16(s[0 * 33], s[1 * 33]); o.y = cvt_pk_bf16(s[2 * 33], s[3 * 33]); o.z = cvt_pk_bf16(s[4 * 33], s[5 * 33]); o.w = cvt_pk_bf16(s[6 * 33], s[7 * 33]); \
                *(u32x4*)(WT + (((size_t)e_ * N + drow0_ + n) * K + k0_ + 64 * hh + 8 * c8) * 2) = o; } } } while (0)
#define TR_PAIR(va_, vb_, ra_) do { const int rca_ = min((ra_), rlast); LAS float* s1_ = scr + 64 * 33; \
        TR_WAIT(); TR_WRITE(va_, scr); if (more_) TR_LOAD(va_, (ra_) + 4 * NGW); TR_WAIT(); TR_WRITE(vb_, s1_); if (more_) TR_LOAD(vb_, (ra_) + 4 * NGW + 1); \
        LDS_WAIT(); asm volatile("" ::: "memory"); \
        TR_EMIT2(rca_, scr, s1_); \
        LDS_WAIT(); asm volatile("" ::: "memory"); } while (0)
    TR_LOAD(v0, r0); TR_LOAD(v1, r0 + 1); TR_LOAD(v2, r2); TR_LOAD(v3, r2 + 1);
    for (int it = 0; it < npw; it += 2) {
        const bool more_ = it + 2 < npw;
        TR_PAIR(v0, v1, r0); r0 += 4 * NGW;
        TR_PAIR(v2, v3, r2); r2 += 4 * NGW;
    }
    asm volatile("s_waitcnt vmcnt(0)" ::: "memory");
#undef TR_PAIR
#undef TR_WAIT
#undef TR_EMIT2
#undef TR_P4
#undef TR_WRITE
#undef TR_LOAD
#undef TR_NB
#undef TR_KB
}
template <bool GUPERM>
__device__ __forceinline__ void transpose_range_f8(const float* __restrict__ W, int K, int N, unsigned char* __restrict__ WT, int rlo, int rhi, float scale, int gw, int NGW, LAS unsigned* scr, int lane) {
    const int nblk = N / 32, ipe = (K / 64) * nblk, nitems = rhi;
    const int kg = lane >> 3, c = lane & 7;
    const unsigned loff = (unsigned)(4 * kg * N + 4 * c) * 4u;
    f32x4 v0[8], v1[8], v2[8], v3[8];
    const int npw = (nitems - (rlo + 2 * gw) + 2 * NGW - 1) / (2 * NGW);
    if (nitems - (rlo + 2 * gw) <= 0) return;
    int r0 = rlo + 2 * gw, r2 = r0 + 2 * NGW;
    constexpr int TS = 32 * 20;
#define TR_KB(rr_) (2 * ((rr_) / (2 * nblk)) + ((rr_) & 1))
#define TR_NB(rr_) (((rr_) % (2 * nblk)) >> 1)
#define T8_LOAD(v_, r_) do { const int ru_ = __builtin_amdgcn_readfirstlane(r_); const int e_ = ru_ / ipe, rr_ = ru_ % ipe; \
        const char* ub_ = (const char*)W + ((size_t)e_ * K * N + (size_t)(TR_KB(rr_) * 64) * N + TR_NB(rr_) * 32) * 4; \
        _Pragma("unroll") for (int i_ = 0; i_ < 8; ++i_) asm volatile("global_load_dwordx4 %0, %1, %2 nt" : "=v"(v_[i_]) : "v"(loff), "s"(ub_ + (size_t)(32 * (i_ >> 2) + (i_ & 3)) * N * 4) : "memory"); } while (0)
#define T8_WAIT() do { if (more_) asm volatile("s_waitcnt vmcnt(24)" ::: "memory"); else asm volatile("s_waitcnt vmcnt(0)" ::: "memory"); } while (0)
#define T8_WRITE(v_, t_) do { _Pragma("unroll") for (int q_ = 0; q_ < 2; ++q_) _Pragma("unroll") for (int m_ = 0; m_ < 4; ++m_) \
        (t_)[(4 * c + m_) * 20 + 8 * q_ + kg] = pk4_fp8(v_[4 * q_][m_] * scale, v_[4 * q_ + 1][m_] * scale, v_[4 * q_ + 2][m_] * scale, v_[4 * q_ + 3][m_] * scale); } while (0)
#define T8_PAIR(va_, vb_, ra_, t0_) do { const int rca_ = (ra_); LAS unsigned* t1_ = (t0_) + TS; \
        T8_WAIT(); T8_WRITE(va_, t0_); if (more_) T8_LOAD(va_, rca_ + 4 * NGW); T8_WAIT(); T8_WRITE(vb_, t1_); if (more_) T8_LOAD(vb_, rca_ + 4 * NGW + 1); \
        LDS_WAIT(); asm volatile("" ::: "memory"); \
        { const int e_ = rca_ / ipe, rr_ = rca_ % ipe, k0_ = TR_KB(rr_) * 64, n0_ = TR_NB(rr_) * 32; \
          const int drow0_ = GUPERM ? ((n0_ & 2047) >> 7) * 256 + (n0_ >> 11) * 128 + (n0_ & 127) : n0_; \
            \
          const int n = lane >> 3, h = (lane >> 2) & 1, sub = lane & 3; const LAS u32x4* s = (const LAS u32x4*)((h ? t1_ : (t0_)) + n * 20 + sub * 4); \
          const u32x4 o0 = s[0], o1 = s[40], o2 = s[80], o3 = s[120]; \
          unsigned char* dst = WT + ((((size_t)e_ * (N / 256) + (drow0_ >> 8)) * (K / 128) + (k0_ >> 7)) << 15) + (drow0_ & 255) * 128 + lane * 16; \
          *(u32x4*)dst = o0; *(u32x4*)(dst + 1024) = o1; *(u32x4*)(dst + 2048) = o2; *(u32x4*)(dst + 3072) = o3; } } while (0)
    T8_LOAD(v0, r0); T8_LOAD(v1, r0 + 1);
    if (npw > 1) { T8_LOAD(v2, r2); T8_LOAD(v3, r2 + 1); }
    for (int it = 0; it < npw; it += 2) {
        { const bool more_ = it + 2 < npw; T8_PAIR(v0, v1, r0, scr); r0 += 4 * NGW; }
        if (it + 1 < npw) { const bool more_ = it + 3 < npw; T8_PAIR(v2, v3, r2, scr + 2 * TS); r2 += 4 * NGW; }
    }
    asm volatile("s_waitcnt vmcnt(0) lgkmcnt(0)" ::: "memory");
#undef T8_PAIR
#undef T8_WRITE
#undef T8_WAIT
#undef T8_LOAD
#undef TR_NB
#undef TR_KB
}
__device__ __forceinline__ void adaln_unit(int unit, const float* __restrict__ c, const float* __restrict__ w_ada, float* __restrict__ modp, LAS float* lds) {
    const int nc = unit % 24, kc = unit / 24, tid = threadIdx.x;
    LAS float* sc = lds; LAS float* red = lds + 2048;
    __syncthreads();
    for (int i = tid; i < 2048; i += 512) { const int k = i >> 3, b = i & 7; const float v = c[b * 2048 + kc * 256 + k]; sc[i] = v / (1.f + expf(-v)); }
    __syncthreads();
    const int c4 = tid & 127, ks = tid >> 7;
    f32x4 acc[8];
#pragma unroll
    for (int b = 0; b < 8; ++b) acc[b] = (f32x4){0.f, 0.f, 0.f, 0.f};
    const float* wp = w_ada + (size_t)(kc * 256) * 12288 + nc * 512 + c4 * 4;
#pragma unroll 16
    for (int j = 0; j < 64; ++j) { const int k = ks + 4 * j; const f32x4 w = __builtin_nontemporal_load((const f32x4*)(wp + (size_t)k * 12288));
        const f32x4 s0 = *(const LAS f32x4*)(sc + k * 8), s1 = *(const LAS f32x4*)(sc + k * 8 + 4);
        acc[0] += s0[0] * w; acc[1] += s0[1] * w; acc[2] += s0[2] * w; acc[3] += s0[3] * w; acc[4] += s1[0] * w; acc[5] += s1[1] * w; acc[6] += s1[2] * w; acc[7] += s1[3] * w; }
#pragma unroll
    for (int b = 0; b < 8; ++b) *(LAS f32x4*)(red + (ks * 8 + b) * 512 + c4 * 4) = acc[b];
    __syncthreads();
    for (int o = tid; o < 4096; o += 512) { const float s = (red[o] + red[4096 + o]) + (red[8192 + o] + red[12288 + o]); const int b = o >> 9, n = o & 511;
        modp[((size_t)kc * 8 + b) * 12288 + nc * 512 + n] = s; }
}
__device__ __forceinline__ float mod_value(const float* __restrict__ modp, const float* __restrict__ b_ada, int b, int n) {
    float s = b_ada[n];
#pragma unroll
    for (int kc = 0; kc < 8; ++kc) s += modp[((size_t)kc * 8 + b) * 12288 + n];
    return s;
}

__device__ __forceinline__ void norm_row2_bf16(const float* __restrict__ xrow0, bf16_t* __restrict__ orow0, const LAS float* a, const LAS float* sh, int lane) {
    const f32x4* xr0 = (const f32x4*)xrow0; const f32x4* xr1 = (const f32x4*)(xrow0 + D);
    f32x4 v0[8], v1[8]; float s0 = 0.f, s1 = 0.f;
#pragma unroll
    for (int j = 0; j < 8; ++j) { v0[j] = __builtin_nontemporal_load(xr0 + j * 64 + lane); v1[j] = __builtin_nontemporal_load(xr1 + j * 64 + lane); }
#pragma unroll
    for (int j = 0; j < 8; ++j) { s0 += (v0[j][0] * v0[j][0] + v0[j][1] * v0[j][1]) + (v0[j][2] * v0[j][2] + v0[j][3] * v0[j][3]); s1 += (v1[j][0] * v1[j][0] + v1[j][1] * v1[j][1]) + (v1[j][2] * v1[j][2] + v1[j][3] * v1[j][3]); }
#pragma unroll
    for (int o = 32; o >= 1; o >>= 1) { s0 += __shfl_xor(s0, o); s1 += __shfl_xor(s1, o); }
    const float r0 = rsqrtf(s0 * (1.f / D) + RMS_EPS), r1 = rsqrtf(s1 * (1.f / D) + RMS_EPS);
#pragma unroll
    for (int j = 0; j < 8; ++j) { const f32x4 aa = *(const LAS f32x4*)(a + (j * 64 + lane) * 4), ss4 = *(const LAS f32x4*)(sh + (j * 64 + lane) * 4);
        const f32x4 o0 = v0[j] * r0 * aa + ss4, o1 = v1[j] * r1 * aa + ss4; u32x2 w0, w1; w0.x = cvt_pk_bf16(o0[0], o0[1]); w0.y = cvt_pk_bf16(o0[2], o0[3]); w1.x = cvt_pk_bf16(o1[0], o1[1]); w1.y = cvt_pk_bf16(o1[2], o1[3]);
        *(u32x2*)(orow0 + (j * 64 + lane) * 4) = w0; *(u32x2*)(orow0 + D + (j * 64 + lane) * 4) = w1; }
}

__device__ __forceinline__ void attn_phase(const Args& args, LAS unsigned char* lds, int vcu, int G) {
    const int tid = threadIdx.x, wid = __builtin_amdgcn_readfirstlane(tid >> 6);
    unsigned char* ws = args.ws;
    LAS float* t5 = (LAS float*)(lds + att::OFF_T5); LAS float* rpbt = (LAS float*)(lds + att::OFF_RPB_A);
    __syncthreads();
    { const float* relb = args.in[13]; const float* rpb = args.in[8];
      for (int i = tid; i < 4 * att::T5N; i += 512) { const int h = i / att::T5N, rel = min(max(i % att::T5N - att::T5C, -128), 128); t5[i] = relb[t5_bucket(rel) * 4 + h] * att::ISCALE; }
      for (int i = tid; i < 8 * 465; i += 512) rpbt[i] = rpb[i] * att::ISCALE; }
    __syncthreads();
    constexpr int NDIFF = NB * 4 * 8, NNAT = NB * 8 * 8;
#define P3_CONVERT() do {\
                __syncthreads();                                       \
                int tc_ = threadIdx.x; asm volatile("" : "+v"(tc_));   \
                { const int lane_ = tc_ & 63; LAS float* scr = (LAS float*)(lds + wid * 17408); const int gw = vcu * 8 + wid, NGW = G * 8;\
                  transpose_range_f8<true>(args.in[18], D, 4096, ws + WS_WGU, GU_SPLIT3, NE * 4096, (float)(1 << WSH), gw, NGW, (LAS unsigned*)scr, lane_);\
                  transpose_range_f8<false>(args.in[20], DFF, D, ws + WS_WDN, DN_SPLIT3, NE * 2048, (float)(1 << WSH), gw, NGW, (LAS unsigned*)scr, lane_); }\
                __syncthreads();                                       \
                { const float* relb = args.in[13]; const float* rpb = args.in[8];\
                  for (int i = tc_; i < 4 * att::T5N; i += 512) { const int hh = i / att::T5N, rel = min(max(i % att::T5N - att::T5C, -128), 128); t5[i] = relb[t5_bucket(rel) * 4 + hh] * att::ISCALE; }\
                  for (int i = tc_; i < 8 * 465; i += 512) rpbt[i] = rpb[i] * att::ISCALE; }\
                __syncthreads();\
            } while (0)
    const int conv_slot = vcu % CONV_SLOTS; int step = 0;
    for (int u = vcu; u < NDIFF + NNAT; u += G) {
        const int mode = u < NDIFF ? 0 : 1;
        int b, h, q0, NT, tbase, npass, qoff, koff, voff, ooff;
        att::TileCtx ctx; ctx.mode = mode;
        if (mode == 0) { const int qb = u & 7; h = (u >> 3) & 3; b = u >> 5; q0 = qb * 256; NT = 32; tbase = 0; npass = 2; qoff = 3072 + h * 256; koff = 4096 + h * 256; voff = 5120 + h * 256; ooff = 1024 + h * 256;
            ctx.tab = t5 + h * att::T5N; ctx.qw0 = q0 + wid * 32; ctx.r0 = 0; ctx.c0 = 0; ctx.kb16 = 0; ctx.rs_u = 0; }
        else { const int un = u - NDIFF; const int rq = un & 7; h = (un >> 3) & 7; b = un >> 6; const int r0 = rq * 4; q0 = r0 * 64; npass = 1; qoff = h * 128; koff = 1024 + h * 128; voff = 2048 + h * 128; ooff = h * 128;
            ctx.tab = rpbt + h * 465; ctx.qw0 = 0; ctx.r0 = r0; ctx.c0 = 8 * wid; ctx.kb16 = min(max(((8 * wid - 8) >> 4) << 4, 0), 32);
            ctx.rs_u = min(max(r0 - 4, 0), 24);
            const int rs_last = min(max(r0 - 1, 0), 24); NT = (rs_last + 8 - ctx.rs_u + 1) & ~1; tbase = ctx.rs_u; }
        const bf16_t* base = (const bf16_t*)(ws + WS_QKV) + (size_t)b * S * INW;
#pragma unroll 1
        for (int pass = 0; pass < npass; ++pass) {
            if (step++ == conv_slot) { P3_CONVERT(); }
            if (mode == 0) {
                f32x16 o[8]; float rl[16];
                att::attn_pass_w(base + (size_t)q0 * INW + qoff + pass * 128, base + koff + pass * 128, base + voff, NT, ctx, (LAS char*)lds, o, rl);
                int tl = threadIdx.x; asm volatile("" : "+v"(tl));
                const int lane = tl & 63, r32 = lane & 31, hi = lane >> 5;
                const char* sb = (const char*)(ws + WS_STASH) + (size_t)blockIdx.x * (256 * 512 * 4);
                asm volatile("" : "+s"(sb));
                const unsigned svo = (unsigned)tl * 16u;
#define ST4P(j) ((__attribute__((address_space(1))) f32x4*)((__attribute__((address_space(1))) char*)sb + (size_t)(j) * 8192 + svo))
                {
#pragma unroll
                    for (int d = 0; d < 8; ++d)
#pragma unroll
                        for (int qq = 0; qq < 4; ++qq) *ST4P(pass * 32 + d * 4 + qq) = (f32x4){o[d][4 * qq] * rl[4 * qq], o[d][4 * qq + 1] * rl[4 * qq + 1], o[d][4 * qq + 2] * rl[4 * qq + 2], o[d][4 * qq + 3] * rl[4 * qq + 3]};
                }
                if (pass == 1) {
                    const float lam = ((const float*)(ws + WS_MISC))[0]; const float* subg = args.in[12];
                    float gsub[8];
#pragma unroll
                    for (int d = 0; d < 8; ++d) gsub[d] = subg[d * 32 + r32];
                    bf16_t* orow = (bf16_t*)(ws + WS_MIX) + ((size_t)b * S + q0 + wid * 32 + 4 * hi) * D + ooff + r32;
#pragma unroll
                    for (int qq = 0; qq < 4; ++qq) {
                        f32x4 a[8], c[8];
#pragma unroll
                        for (int d = 0; d < 8; ++d) { a[d] = *ST4P(d * 4 + qq); c[d] = *ST4P(32 + d * 4 + qq); }
#pragma unroll
                        for (int d = 0; d < 8; ++d) a[d] = a[d] - lam * c[d];
#pragma unroll
                        for (int k = 0; k < 4; ++k) { float s = 0.f;
#pragma unroll
                            for (int d = 0; d < 8; ++d) s += a[d][k] * a[d][k];
#pragma unroll
                            for (int off = 16; off >= 1; off >>= 1) s += __shfl_xor(s, off);
                            const float rstd = rsqrtf(s * (1.f / 256.f) + RMS_EPS) * 0.8f; const int row = att::crow(4 * qq + k, 0);
#pragma unroll
                            for (int d = 0; d < 8; ++d) orow[(size_t)row * D + d * 32] = (bf16_t)(cvt_pk_bf16(a[d][k] * rstd * gsub[d], 0.f) & 0xffffu); }
                        asm volatile("" ::: "memory"); }
                }
#undef ST4P
            } else {
                f32x16 o[4];
                att::attn_pass<1>(base + (size_t)q0 * INW + qoff, base + koff, base + voff, NT, tbase, 31, ctx, (LAS char*)lds, o);
                int tl = threadIdx.x; asm volatile("" : "+v"(tl));
                const int lane = tl & 63, r32 = lane & 31, hi = lane >> 5;
                bf16_t* onat = (bf16_t*)(ws + WS_MIX) + ((size_t)b * S + q0 + 8 * wid + 4 * hi) * D + ooff + r32;
#pragma unroll
                for (int r = 0; r < 16; ++r) { const int row = (r >> 2) * 64 + (r & 3);
#pragma unroll
                    for (int d = 0; d < 4; ++d) onat[(size_t)row * D + d * 32] = (bf16_t)(cvt_pk_bf16(o[d][r], 0.f) & 0xffffu); }
            }
        }
    }
    if (step <= conv_slot) { P3_CONVERT(); }
#undef P3_CONVERT
}

__device__ __forceinline__ void router_phase(const Args& args, LAS unsigned char* lds, int vcu, int G) {
    const int tid = threadIdx.x, wid = __builtin_amdgcn_readfirstlane(tid >> 6), lane = tid & 63;
    unsigned char* ws = args.ws;
    const float* x1 = args.out; const float* g2 = args.in[15]; const float* rw = args.in[16]; const float* rb = args.in[17];
    const float* mod = (const float*)(ws + WS_MOD);
    unsigned char* H2 = (unsigned char*)(ws + WS_H2); unsigned* cnt = (unsigned*)(ws + WS_CTL) + CW_CNT; int* list = (int*)(ws + WS_LIST); float* gate = (float*)(ws + WS_GATE);
    LAS float* a = (LAS float*)lds; LAS float* sh = a + 2048; LAS float* rs = sh + 2048  ; LAS float* part = rs + 64  ;
    LAS float* stg = part + 4 * 64 * 33 + wid * (32 * 68);
    int curb = -1;
    for (int u = vcu; u < M / 64; u += G) {
        const int row0 = u * 64, b = row0 >> 11;
        __syncthreads();
        if (b != curb) { curb = b;
            for (int i = tid; i < 2048; i += 512) { a[i] = g2[i] * (1.f + mod[b * 12288 + 8192 + i]); sh[i] = mod[b * 12288 + 6144 + i]; }
            __syncthreads(); }
#pragma unroll 1
        for (int i = 0; i < 8; i += 2) { const int row = row0 + wid * 8 + i;
            const f32x4* xr0 = (const f32x4*)(x1 + (size_t)row * D); const f32x4* xr1 = xr0 + D / 4;
            f32x4 v0[8], v1[8]; float s0 = 0.f, s1 = 0.f;
#pragma unroll
            for (int j = 0; j < 8; ++j) { v0[j] = xr0[j * 64 + lane]; v1[j] = xr1[j * 64 + lane]; }
#pragma unroll
            for (int j = 0; j < 8; ++j) { s0 += (v0[j][0] * v0[j][0] + v0[j][1] * v0[j][1]) + (v0[j][2] * v0[j][2] + v0[j][3] * v0[j][3]); s1 += (v1[j][0] * v1[j][0] + v1[j][1] * v1[j][1]) + (v1[j][2] * v1[j][2] + v1[j][3] * v1[j][3]); }
#pragma unroll
            for (int o = 32; o >= 1; o >>= 1) { s0 += __shfl_xor(s0, o); s1 += __shfl_xor(s1, o); }
            const float r0 = rsqrtf(s0 * (1.f / D) + RMS_EPS), r1 = rsqrtf(s1 * (1.f / D) + RMS_EPS);
            if (lane == 0) { rs[wid * 8 + i] = r0; rs[wid * 8 + i + 1] = r1; }
            unsigned char* orow = H2 + (size_t)row * D;
#pragma unroll
            for (int j = 0; j < 8; ++j) { const f32x4 aa = *(const LAS f32x4*)(a + (j * 64 + lane) * 4), s4 = *(const LAS f32x4*)(sh + (j * 64 + lane) * 4);
                const f32x4 o0 = v0[j] * r0 * aa + s4, o1 = v1[j] * r1 * aa + s4;
                *(unsigned*)(orow + (j * 64 + lane) * 4) = pk4_fp8(o0[0], o0[1], o0[2], o0[3]); *(unsigned*)(orow + D + (j * 64 + lane) * 4) = pk4_fp8(o1[0], o1[1], o1[2], o1[3]); } }
        __syncthreads();
        { const int tt = wid & 1, kq = wid >> 1; const int tok = lane & 31, kh = lane >> 5;
          const int sr = lane >> 4, sc = (lane & 15) * 4;
          const float* xb = x1 + (size_t)(row0 + tt * 32 + sr) * D + kq * 512 + sc;
          const float* wp = rw + (size_t)(kq * 512 + 4 * kh) * 32 + tok;
          f32x4 xn[8];
#pragma unroll
          for (int i = 0; i < 8; ++i) xn[i] = *(const f32x4*)(xb + (size_t)(4 * i) * D);
          f32x16 acc = f32x16{};
#pragma unroll 1
          for (int ch = 0; ch < 8; ++ch) {
              const int kb = kq * 512 + ch * 64;
              { const f32x4 aa = *(const LAS f32x4*)(a + kb + sc), s4 = *(const LAS f32x4*)(sh + kb + sc);
#pragma unroll
                for (int i = 0; i < 8; ++i) { const float rstd = rs[tt * 32 + 4 * i + sr]; *(LAS f32x4*)(stg + (4 * i + sr) * 68 + sc) = xn[i] * rstd * aa + s4; } }
              if (ch + 1 < 8) {
#pragma unroll
                  for (int i = 0; i < 8; ++i) xn[i] = *(const f32x4*)(xb + (size_t)(4 * i) * D + (ch + 1) * 64); }
              float w[32];
#pragma unroll
              for (int q = 0; q < 32; ++q) w[q] = wp[(size_t)(ch * 64 + 8 * (q >> 2) + (q & 3)) * 32];
#pragma unroll
              for (int m = 0; m < 8; ++m) { const f32x4 hv = *(const LAS f32x4*)(stg + tok * 68 + 8 * m + 4 * kh);
                  acc = __builtin_amdgcn_mfma_f32_32x32x2f32(hv[0], w[4 * m + 0], acc, 0, 0, 0);
                  acc = __builtin_amdgcn_mfma_f32_32x32x2f32(hv[1], w[4 * m + 1], acc, 0, 0, 0);
                  acc = __builtin_amdgcn_mfma_f32_32x32x2f32(hv[2], w[4 * m + 2], acc, 0, 0, 0);
                  acc = __builtin_amdgcn_mfma_f32_32x32x2f32(hv[3], w[4 * m + 3], acc, 0, 0, 0); }
          }
#pragma unroll
          for (int r = 0; r < 16; ++r) part[(kq * 64 + tt * 32 + att::crow(r, kh)) * 33 + tok] = acc[r];
        }
        __syncthreads();
        if (wid == 0) {
            float lg[32];
#pragma unroll
            for (int e = 0; e < 32; ++e) lg[e] = ((part[(0 * 64 + lane) * 33 + e] + part[(1 * 64 + lane) * 33 + e]) + (part[(2 * 64 + lane) * 33 + e] + part[(3 * 64 + lane) * 33 + e])) + rb[e];
            int idx[4]; float val[4];
#pragma unroll
            for (int k = 0; k < 4; ++k) {
                float bv = -3.0e38f; int bi = 0;
#pragma unroll
                for (int e = 0; e < 32; ++e) { const bool take = lg[e] > bv; bv = take ? lg[e] : bv; bi = take ? e : bi; }
                idx[k] = bi; val[k] = bv;
#pragma unroll
                for (int e = 0; e < 32; ++e) lg[e] = (e == bi) ? -3.0e38f : lg[e];
            }
            const float e1 = expf(val[1] - val[0]), e2 = expf(val[2] - val[0]), e3 = expf(val[3] - val[0]);
            const float inv = 1.f / (1.f + e1 + e2 + e3);
            const float gk[4] = {inv, e1 * inv, e2 * inv, e3 * inv};
            LAS unsigned* hist = (LAS unsigned*)rs;
            if (lane < 32) hist[lane] = 0u;
            asm volatile("s_waitcnt lgkmcnt(0)" ::: "memory");
            unsigned rank[4];
#pragma unroll
            for (int k = 0; k < 4; ++k) rank[k] = __hip_atomic_fetch_add(hist + idx[k], 1u, __ATOMIC_RELAXED, __HIP_MEMORY_SCOPE_WORKGROUP);
            asm volatile("s_waitcnt lgkmcnt(0)" ::: "memory");
            if (lane < 32) { const unsigned c = hist[lane]; hist[32 + lane] = c ? atomicAdd(&cnt[lane * 32], c) : 0u; }
            asm volatile("s_waitcnt vmcnt(0) lgkmcnt(0)" ::: "memory");
            const int row = row0 + lane;
#pragma unroll
            for (int k = 0; k < 4; ++k) { const unsigned pos = hist[32 + idx[k]] + rank[k]; *(u32x2*)(list + (idx[k] * 16384 + pos) * 2) = (u32x2){(unsigned)(row * 4 + k), __float_as_uint(gk[k])}; }
        }
    }
}

__device__ __forceinline__ int moe_tables(const unsigned* __restrict__ cntg, LAS int* tb) {
    LAS int* base = tb; LAS int* cn = tb + 40; LAS int* tile_e = tb + 80;
    __syncthreads();
    if (threadIdx.x == 0) { int acc = 0; for (int e = 0; e < 32; ++e) { const int c = (int)__hip_atomic_load(cntg + e * 32, RLX_AGENT); base[e] = acc; cn[e] = c; acc += (c + 255) & ~255; } base[32] = acc; }
    __syncthreads();
    const int nt = base[32] >> 8;
    for (int t = threadIdx.x; t < nt; t += 512) { int e = 0; while (base[e + 1] <= t * 256) ++e; tile_e[t] = e; }
    __syncthreads();
    return nt;
}
__global__ void __launch_bounds__(512, 2) fwd(Args args) {
    extern __shared__ __attribute__((aligned(16))) unsigned char lds_raw[];
    LAS unsigned char* lds = (LAS unsigned char*)lds_raw;
    volatile LAS unsigned* MISC = (volatile LAS unsigned*)(lds + LDSCTL_OFF);
    const int tid = threadIdx.x, lane = tid & 63, wave = __builtin_amdgcn_readfirstlane(tid >> 6);
    const int G = gridDim.x; const int bx = blockIdx.x; const int vcu = (G % 8 == 0) ? (bx % 8) * (G / 8) + bx / 8 : bx;
    unsigned char* ws = args.ws;
    unsigned* ctl = (unsigned*)(ws + WS_CTL);
    for (int u = tid; u < 64; u += 512) ((LAS unsigned*)(lds + LDSCTL_OFF))[u] = 0u;
    __syncthreads();
    XcdBarrier bar = xcd_barrier_post(ctl + CW_BAR, MISC + 8);
    const int lo = args.ph_lo, hi = args.ph_hi;
#ifndef PHASES
#define PHASES 0x1ff
#endif
#define IN(k) (((PHASES >> (k)) & 1) && lo <= (k) && (k) < hi)
#define BOTH(k) (IN(k) && IN((k) + 1))
#ifndef DUPMASK
#define DUPMASK 0
#endif
#define NREP(k) ((((DUPMASK) >> (k)) & 1) + 1)
#define PHASE_BEGIN(k) if (IN(k)) { _Pragma("unroll") for (int rep_ = 0; rep_ < NREP(k); ++rep_) {
#define PHASE_END(k) if (BOTH(k) || rep_ + 1 < NREP(k)) GRID_BAR(); } }
#define GRID_BAR() xcd_barrier(bar)
    const float* x = args.in[0];
    float* modp = (float*)(ws + WS_MODP); float* mod = (float*)(ws + WS_MOD);
    bf16_t* WinT = (bf16_t*)(ws + WS_WIN); bf16_t* WoT = (bf16_t*)(ws + WS_WO); unsigned char* WguT = ws + WS_WGU; unsigned char* WdnT = ws + WS_WDN;
    bf16_t* XN = (bf16_t*)(ws + WS_XN); bf16_t* QKV = (bf16_t*)(ws + WS_QKV); bf16_t* MIX = (bf16_t*)(ws + WS_MIX); unsigned char* H2 = ws + WS_H2;
    unsigned char* ACT = ws + WS_ACT; unsigned char* Y = ws + WS_Y;

    PHASE_BEGIN(0)
        for (int u = vcu; u < 192; u += G) adaln_unit(u, args.in[1], args.in[2], modp, (LAS float*)lds);
        __syncthreads();
        if (bx == 0 && wave == 0) { const float* lam = args.in[11];
            float a = lam[lane] * lam[128 + lane] + lam[64 + lane] * lam[192 + lane];
            float b = lam[256 + lane] * lam[384 + lane] + lam[320 + lane] * lam[448 + lane];
            a = wave_sum(a); b = wave_sum(b);
            if (lane == 0) ((float*)(ws + WS_MISC))[0] = expf(a) - expf(b) + 0.2f; }
        LAS float* scr = (LAS float*)(lds + wave * 17408);
        const int gw = vcu * 8 + wave, NGW = G * 8;
        transpose_range<false, false>(args.in[5], D, INW, (unsigned char*)WinT, 0, 32 * 192, 1.f, gw, NGW, scr, lane);
        transpose_range<false, false>(args.in[14], D, D, (unsigned char*)WoT, 0, 32 * 64, 1.f, gw, NGW, scr, lane);
        transpose_range_f8<true>(args.in[18], D, 4096, WguT, 0, (args.flags & 16) ? NE * 4096 : GU_SPLIT, (float)(1 << WSH), gw, NGW, (LAS unsigned*)scr, lane);
        transpose_range_f8<false>(args.in[20], DFF, D, WdnT, 0, (args.flags & 16) ? NE * 2048 : DN_SPLIT, (float)(1 << WSH), gw, NGW, (LAS unsigned*)scr, lane);
    PHASE_END(0)
    PHASE_BEGIN(1)
        for (int i = vcu * 512 + tid; i < 8 * 12288; i += G * 512) mod[i] = mod_value(modp, args.in[3], i / 12288, i % 12288);
        LAS float* a = (LAS float*)lds; LAS float* sh = a + 2048;
        int curb = -1;
        for (int u = vcu; u < M / 64; u += G) {
            const int b = u >> 5;
            if (b != curb) { curb = b; __syncthreads();
                for (int i = tid; i < 2048; i += 512) { a[i] = args.in[4][i] * (1.f + mod_value(modp, args.in[3], b, 2048 + i)); sh[i] = mod_value(modp, args.in[3], b, i); }
                __syncthreads(); }
#pragma unroll 1
            for (int i = 0; i < 8; i += 2) { const int row = u * 64 + wave * 8 + i; norm_row2_bf16(x + (size_t)row * D, XN + (size_t)row * D, a, sh, lane); }
        }
    PHASE_END(1)
    PHASE_BEGIN(2)
        const bool conv = bx >= G - NCONV;
        if (conv) {
            LAS float* scr = (LAS float*)(lds + wave * 17408);
            const int gw = (bx - (G - NCONV)) * 8 + wave, NGW = NCONV * 8;
            transpose_range_f8<true>(args.in[18], D, 4096, WguT, GU_SPLIT, GU_SPLIT3, (float)(1 << WSH), gw, NGW, (LAS unsigned*)scr, lane);
            transpose_range_f8<false>(args.in[20], DFF, D, WdnT, DN_SPLIT, DN_SPLIT3, (float)(1 << WSH), gw, NGW, (LAS unsigned*)scr, lane);
            __syncthreads();
        }
        if (!(args.flags & 1)) {
        pg8::DenseSched S; S.A = XN; S.Bt = WinT; S.RB = D * 2; S.ord.init(M / 256, INW / 256, conv ? NCONV : G - NCONV, conv ? bx - (G - NCONV) : bx);
        if (conv) S.ord.lo = P2_RR * (G - NCONV); else S.ord.hi = P2_RR * (G - NCONV);
        { LAS float* gt = (LAS float*)(lds + GTAB_OFF); const int which = tid >> 7, j = tid & 127;
          gt[tid] = (which == 0 ? args.in[6] : which == 1 ? args.in[7] : which == 2 ? args.in[9] : args.in[10])[j]; }
        __syncthreads();
        pg8::EpiQKV E{QKV, (const LAS float*)(lds + GTAB_OFF), (LAS float*)(lds + EXCH_OFF)};
        pg8::gemm_phase<pg8::EpiQKV, pg8::DenseSched, true>(lds + RING_OFF, D * 2, S, E);
        }
    PHASE_END(2)
    PHASE_BEGIN(3)
        attn_phase(args, lds, vcu, G);
    PHASE_END(3)
    PHASE_BEGIN(4)
        __syncthreads();
        pg8::DenseSched S; S.A = MIX; S.Bt = WoT; S.RB = D * 2; S.ord.init(M / 256, D / 256, G, bx);
        pg8::EpiResid E{x, mod + 4096, args.out};
        pg8::gemm_phase<pg8::EpiResid, pg8::DenseSched, true>(lds + RING_OFF, D * 2, S, E);
    PHASE_END(4)
    PHASE_BEGIN(5)
        router_phase(args, lds, vcu, G);
    PHASE_END(5)
    PHASE_BEGIN(6)
        LAS int* tb = (LAS int*)(lds + EXCH_OFF);
        const int nMt = moe_tables(ctl + CW_CNT, tb);
        pg8::MoeSched<true> S; S.A = H2; S.Bt = WguT; S.RB = D; S.NperE = 4096; S.ord.init(nMt, 16, G, bx); S.tile_e = tb + 80; S.base = tb; S.cnt = tb + 40; S.list = (const int*)(ws + WS_LIST);
        pg8::EpiSwiglu E{args.in[19], ACT, lds + EPI_OFF, (const int*)(ws + WS_LIST), tb};
        pg8::gemm_phase<pg8::EpiSwiglu, pg8::MoeSched<true>, true, true, 127, 127 - WSH>(lds + RING_OFF, D, S, E);
    PHASE_END(6)
    PHASE_BEGIN(7)
        LAS int* tb = (LAS int*)(lds + EXCH_OFF);
        const int nMt = moe_tables(ctl + CW_CNT, tb);
        pg8::MoeSched<false> S; S.A = ACT; S.Bt = WdnT; S.RB = DFF; S.NperE = 2048; S.ord.init(nMt, 8, G, bx); S.tile_e = tb + 80; S.base = tb; S.cnt = tb + 40; S.list = (const int*)(ws + WS_LIST);
        pg8::EpiDown E{args.in[21], Y, tb, tb + 40, (const int*)(ws + WS_LIST), lds + EPI_OFF};
        pg8::gemm_phase<pg8::EpiDown, pg8::MoeSched<false>, true, true, 127, 127 - WSH>(lds + RING_OFF, DFF, S, E);
    PHASE_END(7)
    if (IN(8)) {
        float* out = args.out;
        constexpr float YS = 1.f / (float)(1 << YSH);
        for (int hc = vcu * 8 + wave; hc < M; hc += G * 8) {
            unsigned w[2][4][4]; f32x4 xv[2][4];
#pragma unroll
            for (int h = 0; h < 2; ++h) { const int hr = hc + h * M, row = hr >> 1, c0 = (hr & 1) * 1024 + 4 * lane;
#pragma unroll
                for (int kk = 0; kk < 4; ++kk)
#pragma unroll
                    for (int q = 0; q < 4; ++q) w[h][kk][q] = __builtin_nontemporal_load((const unsigned*)(Y + ((size_t)row * 4 + kk) * D + c0 + 256 * q));
#pragma unroll
                for (int q = 0; q < 4; ++q) xv[h][q] = __builtin_nontemporal_load((const f32x4*)(out + (size_t)row * D + c0 + 256 * q)); }
#pragma unroll
            for (int h = 0; h < 2; ++h) { const int hr = hc + h * M, row = hr >> 1, c0 = (hr & 1) * 1024 + 4 * lane, b = row >> 11;
#pragma unroll
                for (int q = 0; q < 4; ++q) {
                    f32x4 s = (f32x4){0.f, 0.f, 0.f, 0.f};
#pragma unroll
                    for (int kk = 0; kk < 4; ++kk) { const unsigned ww = w[h][kk][q];
                        const f32x2 lo = __builtin_amdgcn_cvt_pk_f32_fp8((int)ww, false), hi2 = __builtin_amdgcn_cvt_pk_f32_fp8((int)ww, true);
                        s[0] += lo[0]; s[1] += lo[1]; s[2] += hi2[0]; s[3] += hi2[1]; }
                    const f32x4 g = *(const f32x4*)(mod + b * 12288 + 10240 + c0 + 256 * q);
                    __builtin_nontemporal_store(xv[h][q] + g * (s * YS), (f32x4*)(out + (size_t)row * D + c0 + 256 * q)); }
            }
        }
    }
#undef IN
#undef BOTH
#undef GRID_BAR
}
#ifndef STAGE
#define STAGE 9
#endif
#if STAGE < 9
__global__ void __launch_bounds__(256) k_cvt_bf16_f32(const bf16_t* __restrict__ src, float* __restrict__ dst, size_t n4) {
    for (size_t i = (size_t)blockIdx.x * 256 + threadIdx.x; i < n4; i += (size_t)gridDim.x * 256) {
        const u32x2 w = ((const u32x2*)src)[i];
        ((f32x4*)dst)[i] = (f32x4){__uint_as_float(w.x << 16), __uint_as_float(w.x & 0xffff0000u), __uint_as_float(w.y << 16), __uint_as_float(w.y & 0xffff0000u)};
    }
}
#endif
extern "C" void kernel_launch(void* const* d_in, const int* in_sizes, int n_in, void* d_out, int out_size, void* d_ws, size_t ws_size, hipStream_t stream) {
    static int grid = 0;
    if (grid == 0) {
        int dev = 0, cus = 0, per_cu = 0;
        if (hipGetDevice(&dev) != hipSuccess || hipDeviceGetAttribute(&cus, hipDeviceAttributeMultiprocessorCount, dev) != hipSuccess) { fprintf(stderr, "kernel_launch: device query failed\n"); grid = -1; return; }
        if (hipFuncSetAttribute((const void*)fwd, hipFuncAttributeMaxDynamicSharedMemorySize, LDS_BYTES) != hipSuccess) { fprintf(stderr, "kernel_launch: hipFuncSetAttribute failed\n"); grid = -1; return; }
        if (hipOccupancyMaxActiveBlocksPerMultiprocessor(&per_cu, (const void*)fwd, 512, LDS_BYTES) != hipSuccess || per_cu < 1) fprintf(stderr, "kernel_launch: occupancy query reports %d\n", per_cu);
        (void)hipGetLastError();
        grid = cus;
    }
    if (grid < 0) return;
    unsigned char* ws = (unsigned char*)d_ws;
    (void)hipMemsetAsync(ws + WS_CTL, 0, CTL_ZERO_BYTES, stream);
    Args a{};
    for (int i = 0; i < 22; ++i) a.in[i] = (const float*)d_in[i];
    a.out = (float*)d_out; a.ws = ws; a.ph_lo = 0; a.ph_hi = STAGE;
    hipLaunchKernelGGL(fwd, dim3(grid), dim3(512), LDS_BYTES, stream, a);
#if STAGE < 9
    {
        using namespace orc;
        const float* x = (const float*)d_in[0];
        float* out = (float*)d_out;
        unsigned* cnt = (unsigned*)(ws + WS_CTL); float* mod = (float*)(ws + WS_MOD); float* misc = (float*)(ws + WS_MISC); float* gate = (float*)(ws + WS_GATE);
        int* list = (int*)(ws + WS_LIST); int* rowcode = (int*)(ws + WS_ROWCODE); int* tile_e = (int*)(ws + WS_TILEE);
        float* xn = (float*)(ws + WS_TEST); float* proj = (float*)(ws + WS_TEST + 128 * MiB); float* mix = (float*)(ws + WS_TEST + 512 * MiB); float* h2 = (float*)(ws + WS_TEST + 640 * MiB);
        float* act = (float*)(ws + WS_TEST + 768 * MiB); float* Y = (float*)(ws + WS_TEST + 1344 * MiB);
        const float* w_in = (const float*)d_in[5]; const float* w_out = (const float*)d_in[14]; const float* w_gu = (const float*)d_in[18]; const float* b_gu = (const float*)d_in[19];
        const float* w_dn = (const float*)d_in[20]; const float* b_dn = (const float*)d_in[21];
        if (STAGE == 2) k_cvt_bf16_f32<<<4096, 256, 0, stream>>>((const bf16_t*)(ws + WS_XN), xn, (size_t)M * D / 4);
        if (STAGE <= 2) { k_ogemm<EpiStore><<<dim3(INW / 128, M / 128), 256, 0, stream>>>(xn, D, nullptr, w_in, INW, 0, nullptr, D, nullptr, 0, EpiStore{proj, INW});
            k_qknorm<<<M * 32 / 4, 256, 0, stream>>>(proj, (const float*)d_in[6], (const float*)d_in[7], (const float*)d_in[9], (const float*)d_in[10]); }
        if (STAGE == 3) k_cvt_bf16_f32<<<4096, 256, 0, stream>>>((const bf16_t*)(ws + WS_QKV), proj, (size_t)M * INW / 4);
        if (STAGE <= 3) { k_nat<<<NB * 8 * S / 4, 256, 0, stream>>>(proj, (const float*)d_in[8], mix);
            k_diff<<<NB * 4 * 1024, 256, 0, stream>>>(proj, (const float*)d_in[13], (const float*)d_in[12], misc, mix); }
        if (STAGE == 4) k_cvt_bf16_f32<<<4096, 256, 0, stream>>>((const bf16_t*)(ws + WS_MIX), mix, (size_t)M * D / 4);
        if (STAGE <= 4) k_ogemm<EpiResid><<<dim3(D / 128, M / 128), 256, 0, stream>>>(mix, D, nullptr, w_out, D, 0, nullptr, D, nullptr, 0, EpiResid{x, mod, 4096, out});
        if (STAGE <= 5) k_router<<<M / 4, 256, 0, stream>>>(out, (const float*)d_in[15], mod, (const float*)d_in[16], (const float*)d_in[17], h2, cnt, list, gate);
        if (STAGE == 6) k_cvt_bf16_f32<<<4096, 256, 0, stream>>>((const bf16_t*)(ws + WS_H2), h2, (size_t)M * D / 4);
        if (STAGE <= 7) k_tables<<<MAXSLOT / 256, 256, 0, stream>>>(cnt, list, rowcode, tile_e);
        if (STAGE <= 6) k_ogemm<EpiSwiglu><<<dim3(DFF / 64, MAXSLOT / 128), 256, 0, stream>>>(h2, D, rowcode, w_gu, 2 * DFF, (size_t)D * 2 * DFF, tile_e, D, tile_e + 512, 2048, EpiSwiglu{b_gu, act});
        if (STAGE == 7) k_cvt_bf16_f32<<<4096, 256, 0, stream>>>((const bf16_t*)(ws + WS_ACT), act, (size_t)MAXSLOT * DFF / 4);
        if (STAGE <= 7) k_ogemm<EpiDown><<<dim3(D / 128, MAXSLOT / 128), 256, 0, stream>>>(act, DFF, nullptr, w_dn, D, (size_t)DFF * D, tile_e, DFF, tile_e + 512, 0, EpiDown{b_dn, rowcode, gate, Y});
        if (STAGE == 8) k_cvt_bf16_f32<<<4096, 256, 0, stream>>>((const bf16_t*)(ws + WS_Y), Y, (size_t)M * 4 * D / 4);
        if (STAGE <= 8) k_combine<<<M * 512 / 256, 256, 0, stream>>>(out, Y, mod);
    }
#endif
}
```

```cpp
#define STAGE 9
#include <hip/hip_runtime.h>
#include <cstdint>
#include <cstdio>

#define GAS __attribute__((address_space(1)))
#define LAS __attribute__((address_space(3)))
typedef unsigned short bf16_t;
typedef short bf16x8 __attribute__((ext_vector_type(8)));
typedef short s16x4 __attribute__((ext_vector_type(4)));
typedef float f32x2 __attribute__((ext_vector_type(2)));
typedef float f32x4 __attribute__((ext_vector_type(4)));
typedef float f32x16 __attribute__((ext_vector_type(16)));
typedef unsigned u32x4 __attribute__((ext_vector_type(4)));
typedef unsigned u32x2 __attribute__((ext_vector_type(2)));

constexpr int D = 2048, NB = 8, S = 2048, M = NB * S, HD = 128;
constexpr int INW = 6144, NE = 32, DFF = 2048;
constexpr float RMS_EPS = 1e-6f;
constexpr size_t MiB = 1u << 20;
constexpr int MAXSLOT = 73728, MAXTILE = MAXSLOT / 256;
constexpr int P2_RR = 8;
constexpr int NCONV = 64;
constexpr int CONV_E0 = 0, CONV_E2 = 8;
constexpr int CONV_SLOTS = 3;
constexpr int GU_SPLIT = 32 * 4096 * CONV_E0 / 16, DN_SPLIT = 32 * 2048 * CONV_E0 / 16, GU_SPLIT3 = 32 * 4096 * (CONV_E0 + CONV_E2) / 16, DN_SPLIT3 = 32 * 2048 * (CONV_E0 + CONV_E2) / 16;
constexpr int YSH = 4;
constexpr int WSH = 5;
constexpr size_t WS_CTL = 0, CTL_ZERO_BYTES = 1 * MiB;
constexpr size_t WS_MODP = 1 * MiB;
constexpr size_t WS_MOD = 5 * MiB;
constexpr size_t WS_MISC = 6 * MiB;
constexpr size_t WS_GATE = 7 * MiB;
constexpr size_t WS_LIST = 8 * MiB;
constexpr size_t WS_ROWCODE = 10 * MiB;
constexpr size_t WS_TILEE = 11 * MiB;
constexpr size_t WS_WIN = 16 * MiB;
constexpr size_t WS_WO = 40 * MiB;
constexpr size_t WS_XN = 48 * MiB;
constexpr size_t WS_QKV = 112 * MiB;
constexpr size_t WS_MIX = 304 * MiB;
constexpr size_t WS_H2 = 368 * MiB;
constexpr size_t WS_STASH = 432 * MiB;
constexpr size_t WS_WGU = 560 * MiB;
constexpr size_t WS_WDN = 1072 * MiB;
constexpr size_t WS_ACT = 1328 * MiB;
constexpr size_t WS_Y = 1616 * MiB;
constexpr size_t WS_TEST = 2048 * MiB;
constexpr int CW_CNT = 0;
constexpr int CW_BAR = 4096;
constexpr int RING_OFF = 0, RING_BYTES = 131072;
constexpr int EXCH_OFF = RING_BYTES;
constexpr int GTAB_OFF = EXCH_OFF + 8192;
constexpr int LDSCTL_OFF = GTAB_OFF + 2048;
constexpr int EPI_OFF = LDSCTL_OFF + 256;
constexpr int LDS_BYTES = EPI_OFF + 12288;
static_assert(EPI_OFF + 12288 <= LDS_BYTES && LDS_BYTES <= 163840, "LDS map");

#define RLX_AGENT __ATOMIC_RELAXED, __HIP_MEMORY_SCOPE_AGENT
#define LDS_WAIT() asm volatile("s_waitcnt lgkmcnt(0)" ::: "memory")
#define VM_WAIT() asm volatile("s_waitcnt vmcnt(0)" ::: "memory")

__device__ __forceinline__ unsigned cvt_pk_bf16(float lo, float hi) { unsigned r; asm volatile("v_cvt_pk_bf16_f32 %0, %1, %2" : "=v"(r) : "v"(lo), "v"(hi)); return r; }
__device__ __forceinline__ unsigned pk4_fp8(float a, float b, float c, float d) { int r = __builtin_amdgcn_cvt_pk_fp8_f32(a, b, 0, false); r = __builtin_amdgcn_cvt_pk_fp8_f32(c, d, r, true); return (unsigned)r; }
__device__ __forceinline__ float bf2f(unsigned short b) { return __uint_as_float(((unsigned)b) << 16); }
__device__ __forceinline__ float wave_sum(float v) {
#pragma unroll
    for (int o = 32; o >= 1; o >>= 1) v += __shfl_xor(v, o);
    return v;
}
__device__ __forceinline__ float wave_max(float v) {
#pragma unroll
    for (int o = 32; o >= 1; o >>= 1) v = fmaxf(v, __shfl_xor(v, o));
    return v;
}

#define XB_TMO      128
#define XB_XCNT(j)  (256  + 64 * (j))
#define XB_XSUB(j)  (1280 + 64 * (j))
#define XB_XGEN(j)  (2304 + 64 * (j))
#define XB_TOP      3328
#define XB_TOPGEN   3392
#define XCD_BAR_WORDS 3456
#define XB_SPIN_CAP (1u << 18)
__device__ __forceinline__ unsigned xb_ld(unsigned* p)              { return __hip_atomic_load(p, __ATOMIC_RELAXED, __HIP_MEMORY_SCOPE_AGENT); }
__device__ __forceinline__ unsigned xb_add(unsigned* p, unsigned v) { return __hip_atomic_fetch_add(p, v, __ATOMIC_RELAXED, __HIP_MEMORY_SCOPE_AGENT); }
__device__ __forceinline__ unsigned xb_xcc_id() { return (unsigned)__builtin_amdgcn_s_getreg((3 << 11) | 20) & 0xFu; }
#define XB_SPIN(cond, bar) do { unsigned _sp = 0; while (cond) { __builtin_amdgcn_s_sleep(1); \
    if ((++_sp & 255u) == 0u) { if (xb_ld(&(bar)[XB_TMO])) break; if (_sp > XB_SPIN_CAP) { atomicAdd(&(bar)[XB_TMO], 1u); break; } } } } while (0)
struct XcdBarrier { unsigned* bar; unsigned x; volatile LAS unsigned* st; };
__device__ __forceinline__ XcdBarrier xcd_barrier_post(unsigned* bar, volatile LAS unsigned* st) {
    XcdBarrier b; b.bar = bar; b.x = xb_xcc_id(); b.st = st;
    if (threadIdx.x == 0) (void)xb_add(&bar[XB_XCNT(b.x)], 1u);
    return b;
}
__device__ __forceinline__ void xcd_barrier_complete(unsigned* bar, unsigned x, unsigned& nloc, unsigned& nx) {
    const unsigned G = gridDim.x * gridDim.y * gridDim.z;
    unsigned sum, cnt, mine, sp = 0u;
    for (;;) {
        sum = 0u; cnt = 0u; mine = 0u;
#pragma unroll
        for (unsigned j = 0; j < 16; ++j) { const unsigned c = xb_ld(&bar[XB_XCNT(j)]); sum += c; cnt += (c > 0u) ? 1u : 0u; mine = (j == x) ? c : mine; }
        if (sum == G) break;
        __builtin_amdgcn_s_sleep(1);
        if ((++sp & 255u) == 0u) { if (xb_ld(&bar[XB_TMO])) break; if (sp > XB_SPIN_CAP) { atomicAdd(&bar[XB_TMO], 1u); break; } }
    }
    nloc = mine > 0u ? mine : 1u; nx = cnt > 0u ? cnt : 1u;
}
__device__ __forceinline__ void xcd_barrier(const XcdBarrier& b) {
    asm volatile("s_waitcnt vmcnt(0)" ::: "memory");
    __syncthreads();
    if (threadIdx.x == 0) {
        unsigned* bar = b.bar;
        __builtin_amdgcn_s_waitcnt(0);
        unsigned nloc = b.st[0], nx = b.st[1];
        if (nloc == 0u) { xcd_barrier_complete(bar, b.x, nloc, nx); b.st[0] = nloc; b.st[1] = nx; }
        const unsigned old = xb_add(&bar[XB_XSUB(b.x)], 1u);
        const unsigned gen = old / nloc;
        if (old + 1u == (gen + 1u) * nloc) {
            __builtin_amdgcn_fence(__ATOMIC_RELEASE, "agent");
            asm volatile("s_waitcnt vmcnt(0)" ::: "memory");
            const unsigned og = xb_add(&bar[XB_TOP], 1u);
            const unsigned tg = og / nx;
            if (og + 1u == (tg + 1u) * nx) xb_add(&bar[XB_TOPGEN], 1u);
            else XB_SPIN(xb_ld(&bar[XB_TOPGEN]) == tg, bar);
            __builtin_amdgcn_fence(__ATOMIC_ACQUIRE, "agent");
            xb_add(&bar[XB_XGEN(b.x)], 1u);
            asm volatile("s_waitcnt vmcnt(0)" ::: "memory");
        } else {
            XB_SPIN(xb_ld(&bar[XB_XGEN(b.x)]) == gen, bar);
            __builtin_amdgcn_fence(__ATOMIC_ACQUIRE, "agent");
            asm volatile("s_waitcnt vmcnt(0)" ::: "memory");
        }
    }
    __syncthreads();
}
namespace pg8 {
constexpr int BM = 256, BK = 64, HALF = 128, HTB = HALF * BK * 2, STAGE_BYTES = 8 * HTB, NXCD = 8, WGM = 8;
__host__ __device__ __forceinline__ int lds_byte(int r, int c) { const int st = (r >> 4) * 2 + (c >> 5), rr = r & 15, cc = c & 31, ob = rr * 64 + cc * 2; return st * 1024 + (ob ^ (((ob >> 9) & 1) << 5)); }
__host__ __device__ __forceinline__ void stage_rc(int b, int& R, int& C) { const int st = b / 1024, sb = b % 1024, swz = sb ^ (((sb >> 9) & 1) << 5); R = (st >> 1) * 16 + swz / 64; C = (st & 1) * 32 + (swz % 64) / 2; }
__host__ __device__ __forceinline__ int perm32(int rho) { const int n = rho >> 4, i = rho & 15; return 8 * (i >> 2) + 4 * n + (i & 3); }

struct Unit { int pm, pn, e; };

struct StaticOrder {
    int nM, nN, nwg, G, c, lo, hi;
    __device__ void init(int nM_, int nN_, int G_, int c_) { nM = nM_; nN = nN_; nwg = nM * nN; G = G_; c = c_; lo = 0; hi = nwg; }
    __device__ bool next(int i, Unit& u) const {
        const long L = (long)lo + (long)i * G + c; if (L >= hi) return false;
        int wgid = (int)L; { const int q = nwg / NXCD, r = nwg % NXCD, xcd = wgid % NXCD, off = wgid / NXCD; wgid = (xcd < r ? xcd * (q + 1) : r * (q + 1) + (xcd - r) * q) + off; }
        const int nig = WGM * nN, gid = wgid / nig, fm = gid * WGM, gsz = (nM - fm) < WGM ? (nM - fm) : WGM;
        u.pm = fm + ((wgid % nig) % gsz); u.pn = (wgid % nig) / gsz; u.e = 0; return true;
    }
};
struct DenseSched {
    static constexpr bool VARA = false;
    const void* A; const void* Bt; int RB; StaticOrder ord;
    __device__ __forceinline__ bool next(int i, Unit& u) const { return ord.next(i, u); }
    __device__ __forceinline__ const char* a_base(const Unit& u) const { return (const char*)A + (size_t)u.pm * BM * RB; }
    __device__ __forceinline__ const char* b_base(const Unit& u) const { return (const char*)Bt + (size_t)u.pn * BM * RB; }
    __device__ __forceinline__ int b_pitch() const { return RB; }
    __device__ __forceinline__ int b_kstep() const { return BK * 2; }
    __device__ __forceinline__ void a_voff(const Unit&, const int (&R)[2], const int (&C)[2], unsigned (&va)[2][2]) const {
#pragma unroll
        for (int h = 0; h < 2; ++h)
#pragma unroll
            for (int i = 0; i < 2; ++i) va[h][i] = (unsigned)((h * HALF + R[i]) * RB + C[i] * 2);
    }
};
template <bool GATHER> struct MoeSched {
    static constexpr bool VARA = true;
    const void* A; const void* Bt; int RB; int NperE; StaticOrder ord;
    const LAS int* tile_e; const LAS int* base; const LAS int* cnt; const int* list;
    __device__ __forceinline__ bool next(int i, Unit& u) const { if (!ord.next(i, u)) return false; u.e = tile_e[u.pm]; return true; }
    __device__ __forceinline__ const char* a_base(const Unit& u) const { return GATHER ? (const char*)A : (const char*)A + (size_t)u.pm * BM * RB; }
    __device__ __forceinline__ const char* b_base(const Unit& u) const { return (const char*)Bt + ((size_t)u.e * (NperE / BM) + (size_t)u.pn) * (size_t)(RB / 128) * 32768; }
    __device__ __forceinline__ int b_pitch() const { return 128; }
    __device__ __forceinline__ int b_kstep() const { return 32768; }
    __device__ __forceinline__ void a_voff(const Unit& u, const int (&R)[2], const int (&C)[2], unsigned (&va)[2][2]) const {
#pragma unroll
        for (int h = 0; h < 2; ++h)
#pragma unroll
            for (int i = 0; i < 2; ++i) {
                if (GATHER) { const int pos = u.pm * BM + h * HALF + R[i] - base[u.e]; const int code = pos < cnt[u.e] ? list[(u.e * 16384 + pos) * 2] : 0;
                    va[h][i] = (unsigned)((code >> 2) * RB + C[i] * 2); }
                else va[h][i] = (unsigned)((h * HALF + R[i]) * RB + C[i] * 2);
            }
    }
    __device__ __forceinline__ void a_voff_slot(const Unit& u, const int (&R)[2], const int (&C)[2], unsigned (&va)[2][2], const LAS unsigned char* slot) const {
        const int nvalid = cnt[u.e] - (u.pm * BM - base[u.e]); const LAS u32x2* le = (const LAS u32x2*)(slot + 1024);
#pragma unroll
        for (int h = 0; h < 2; ++h)
#pragma unroll
            for (int i = 0; i < 2; ++i) {
                if (GATHER) { const int rl = h * HALF + R[i]; const int code = rl < nvalid ? (int)le[rl].x : 0;
                    va[h][i] = (unsigned)((code >> 2) * RB + C[i] * 2); }
                else va[h][i] = (unsigned)((h * HALF + R[i]) * RB + C[i] * 2);
            }
    }
};

typedef int i32x8 __attribute__((ext_vector_type(8)));
typedef int i32x4_t __attribute__((ext_vector_type(4)));
template <class Epi, class Sched, bool ALIGN_EPI, bool F8 = false, int SCALE_A = 127, int SCALE_B = 127>
__device__ __forceinline__ void gemm_phase(LAS unsigned char* lds, const int RB  , const Sched& S, const Epi& E) {
    const int tid = threadIdx.x, wid = __builtin_amdgcn_readfirstlane(tid >> 6), lane = tid & 63, wr = wid >> 2, wc = wid & 3, fr = lane & 15, fq = lane >> 4;
    const int nt = RB / (BK * 2);
    int Rp[2], Cp[2]; unsigned voffB[2];
#pragma unroll
    for (int i = 0; i < 2; ++i) { stage_rc(tid * 16 + i * 8192, Rp[i], Cp[i]);
        const int Rb = Epi::ADJ ? (64 * (Rp[i] >> 5) + perm32(Rp[i] & 31)) : Epi::PERM ? ((Rp[i] & ~31) + perm32(Rp[i] & 31)) : Rp[i];
        voffB[i] = (unsigned)(Rb * S.b_pitch() + Cp[i] * 2); }
    const size_t kstep = (size_t)(BK * 2);
    const size_t hstepB = (size_t)(Epi::ADJ ? 32 : HALF) * S.b_pitch(), kstepB = (size_t)S.b_kstep();
    const unsigned ldsw = (unsigned)wid * 1024u;
    const int aoff = lds_byte(wr * 64 + fr, fq * 8), boff = lds_byte(wc * 32 + fr, fq * 8);
#define PG8_SA(b, h) (((b) * 2 + (h)) * HTB)
#define PG8_SB(b, h) ((4 + (b) * 2 + (h)) * HTB)
#define PG8_STAGE(bufoff, gbase, voff) do { _Pragma("unroll") for (int _i = 0; _i < 2; ++_i) \
        __builtin_amdgcn_global_load_lds((const unsigned*)((const char*)(gbase) + (voff)[_i]), (LAS unsigned*)(lds + (bufoff) + ldsw + _i * 8192), 16, 0, 0); } while (0)
#define PG8_LDA(dst, b, h) do { _Pragma("unroll") for (int m = 0; m < 4; ++m) _Pragma("unroll") for (int k = 0; k < 2; ++k) dst[m][k] = *(const LAS bf16x8*)(lds + PG8_SA(b, h) + aoff + m * 2048 + k * 1024); } while (0)
#define PG8_LDB(dst, b, h) do { _Pragma("unroll") for (int n = 0; n < 2; ++n) _Pragma("unroll") for (int k = 0; k < 2; ++k) dst[n][k] = *(const LAS bf16x8*)(lds + PG8_SB(b, h) + boff + n * 2048 + k * 1024); } while (0)
#define PG8_CAT(x) __builtin_shufflevector(__builtin_bit_cast(i32x4_t, (x)[0]), __builtin_bit_cast(i32x4_t, (x)[1]), 0, 1, 2, 3, 4, 5, 6, 7)
#define PG8_MMA(ai, bj, At, Bt) do { __builtin_amdgcn_s_setprio(1); _Pragma("unroll") for (int m = 0; m < 4; ++m) _Pragma("unroll") for (int n = 0; n < 2; ++n) { \
        if constexpr (F8) acc[ai][bj][m][n] = __builtin_amdgcn_mfma_scale_f32_16x16x128_f8f6f4(PG8_CAT(Bt[n]), PG8_CAT(At[m]), acc[ai][bj][m][n], 0, 0, 0, SCALE_B * 0x01010101, 0, SCALE_A * 0x01010101); \
        else { _Pragma("unroll") for (int k = 0; k < 2; ++k) acc[ai][bj][m][n] = __builtin_amdgcn_mfma_f32_16x16x32_bf16(Bt[n][k], At[m][k], acc[ai][bj][m][n], 0, 0, 0); } } \
        __builtin_amdgcn_s_setprio(0); } while (0)
#define PG8_WAIT_V(n) asm volatile("s_waitcnt vmcnt(" #n ")" ::: "memory")
#define PG8_WAIT_L(n) asm volatile("s_waitcnt lgkmcnt(" #n ")" ::: "memory")
#define PG8_BAR __builtin_amdgcn_s_barrier()
#define PG8_SCHED __builtin_amdgcn_sched_barrier(0)
    Unit cur, nxt; int ui = 0;
    if (!S.next(0, cur)) return;
    int eslot = 0;
    if constexpr (Epi::PREFETCH) { if (wid == 0) E.prefetch(cur, 0, lane); }
    f32x4 acc[2][2][4][2];
#pragma unroll
    for (int a = 0; a < 2; ++a)
#pragma unroll
        for (int b = 0; b < 2; ++b)
#pragma unroll
            for (int m = 0; m < 4; ++m)
#pragma unroll
                for (int n = 0; n < 2; ++n) acc[a][b][m][n] = (f32x4){0.f, 0.f, 0.f, 0.f};
    bf16x8 At[4][2], B0[2][2], B1[2][2];
    unsigned vaC[2][2];
    S.a_voff(cur, Rp, Cp, vaC);
    const char* cA = S.a_base(cur); const char* cB = S.b_base(cur);
    PG8_STAGE(PG8_SB(0, 0), cB, voffB); PG8_STAGE(PG8_SB(0, 1), cB + hstepB, voffB); PG8_STAGE(PG8_SA(0, 0), cA, vaC[0]); PG8_STAGE(PG8_SA(0, 1), cA, vaC[1]);
    if (wr == 1) PG8_BAR;
    PG8_WAIT_V(2); PG8_BAR;
    PG8_STAGE(PG8_SB(1, 0), cB + kstepB, voffB); PG8_STAGE(PG8_SA(1, 0), cA + kstep, vaC[0]); PG8_STAGE(PG8_SB(1, 1), cB + hstepB + kstepB, voffB);
    PG8_WAIT_V(6); PG8_BAR;
    for (;;) {
        const bool has_next = S.next(ui + 1, nxt);
        const int nslot = eslot == 2 ? 0 : eslot + 1;
        if constexpr (Epi::PREFETCH) { if (has_next && wid == 0) E.prefetch(nxt, nslot, lane); }
        const char* nA = has_next ? S.a_base(nxt) : cA; const char* nB = has_next ? S.b_base(nxt) : cB;
        for (int t = 0; t < nt; t += 2) {
            const bool last = (t == nt - 2);
            const char* a1 = cA + (size_t)(t + 1) * kstep;
            const char* a2 = last ? nA : cA + (size_t)(t + 2) * kstep; const char* b2 = last ? nB : cB + (size_t)(t + 2) * kstepB;
            const char* a3 = a2 + kstep; const char* b3 = b2 + kstepB;
            PG8_LDB(B0, 0, 0); PG8_LDB(B1, 0, 1); PG8_SCHED; PG8_LDA(At, 0, 0); PG8_STAGE(PG8_SA(1, 1), a1, vaC[1]);
            if constexpr (Sched::VARA) { if (last && has_next) {
                int tl = threadIdx.x; asm volatile("" : "+v"(tl));
                int Rn[2], Cn[2];
#pragma unroll
                for (int i = 0; i < 2; ++i) stage_rc(tl * 16 + i * 8192, Rn[i], Cn[i]);
                if constexpr (Epi::PREFETCH) S.a_voff_slot(nxt, Rn, Cn, vaC, E.epi + nslot * 4096); else S.a_voff(nxt, Rn, Cn, vaC); } }
            PG8_WAIT_V(8); PG8_WAIT_L(0); PG8_BAR; PG8_MMA(0, 0, At, B0); PG8_MMA(0, 1, At, B1); PG8_BAR; PG8_SCHED;
            PG8_LDA(At, 0, 1); PG8_STAGE(PG8_SB(0, 0), b2, voffB); PG8_STAGE(PG8_SB(0, 1), b2 + hstepB, voffB); PG8_STAGE(PG8_SA(0, 0), a2, vaC[0]);
            PG8_WAIT_V(8); PG8_WAIT_L(0); PG8_BAR; PG8_MMA(1, 0, At, B0); PG8_MMA(1, 1, At, B1); PG8_BAR; PG8_SCHED;
            PG8_LDB(B0, 1, 0); PG8_LDB(B1, 1, 1); PG8_SCHED; PG8_LDA(At, 1, 0); PG8_STAGE(PG8_SA(0, 1), a2, vaC[1]);
            PG8_WAIT_V(8); PG8_WAIT_L(0); PG8_BAR; PG8_MMA(0, 0, At, B0); PG8_MMA(0, 1, At, B1); PG8_BAR; PG8_SCHED;
            PG8_LDA(At, 1, 1); PG8_STAGE(PG8_SB(1, 0), b3, voffB); PG8_STAGE(PG8_SB(1, 1), b3 + hstepB, voffB); PG8_STAGE(PG8_SA(1, 0), a3, vaC[0]);
            PG8_WAIT_V(8); PG8_WAIT_L(0); PG8_BAR; PG8_MMA(1, 0, At, B0); PG8_MMA(1, 1, At, B1); PG8_BAR; PG8_SCHED;
        }
        if constexpr (ALIGN_EPI) { if (wr == 0) PG8_BAR; }
        { int tl = threadIdx.x; asm volatile("" : "+v"(tl));
          if constexpr (Epi::PREFETCH) E(acc, cur, wr, wc, tl & 15, (tl & 63) >> 4, eslot); else E(acc, cur, wr, wc, tl & 15, (tl & 63) >> 4); }
        if (!has_next) break;
#pragma unroll
        for (int a = 0; a < 2; ++a)
#pragma unroll
            for (int b = 0; b < 2; ++b)
#pragma unroll
                for (int m = 0; m < 4; ++m)
#pragma unroll
                    for (int n = 0; n < 2; ++n) acc[a][b][m][n] = (f32x4){0.f, 0.f, 0.f, 0.f};
        cur = nxt; cA = nA; cB = nB; ++ui; eslot = nslot;
        if constexpr (ALIGN_EPI) { if (wr == 1) PG8_BAR; }
    }
    PG8_WAIT_V(0);
    if constexpr (!ALIGN_EPI) { if (wr == 0) PG8_BAR; }
    PG8_BAR;
#undef PG8_SA
#undef PG8_SB
#undef PG8_STAGE
#undef PG8_LDA
#undef PG8_LDB
#undef PG8_MMA
#undef PG8_CAT
#undef PG8_WAIT_V
#undef PG8_WAIT_L
#undef PG8_BAR
#undef PG8_SCHED
}

struct EpiQKV {
    static constexpr bool PERM = true, ADJ = false, PREFETCH = false;
    bf16_t* O; const LAS float* gtab; LAS float* P;
    __device__ __forceinline__ void operator()(f32x4 (&acc)[2][2][4][2], const Unit& u, int wr, int wc, int fr, int fq) const {
        const int pn = u.pn; const bool norm = (pn < 8) || (pn >= 12 && pn < 20);
        const LAS float* g = gtab + (pn < 4 ? 0 : pn < 8 ? 128 : pn < 16 ? 256 : 384);
        bf16_t* base = O + (size_t)(u.pm * BM + wr * 64 + fr) * INW + pn * BM + wc * 32 + 8 * fq;
        if (norm) {
#pragma unroll
            for (int ai = 0; ai < 2; ++ai)
#pragma unroll
                for (int m = 0; m < 4; ++m)
#pragma unroll
                    for (int bj = 0; bj < 2; ++bj) {
                        const f32x4 a = acc[ai][bj][m][0], b = acc[ai][bj][m][1];
                        float s = (a[0] * a[0] + a[1] * a[1]) + (a[2] * a[2] + a[3] * a[3]) + (b[0] * b[0] + b[1] * b[1]) + (b[2] * b[2] + b[3] * b[3]);
                        s += __shfl_xor(s, 16); s += __shfl_xor(s, 32);
                        if (fq == 0) P[(ai * HALF + wr * 64 + m * 16 + fr) * 8 + bj * 4 + wc] = s;
                    }
            asm volatile("s_waitcnt lgkmcnt(0)" ::: "memory"); __builtin_amdgcn_s_barrier(); asm volatile("" ::: "memory");
            const f32x4 g0 = *(const LAS f32x4*)(g + wc * 32 + 8 * fq), g1 = *(const LAS f32x4*)(g + wc * 32 + 8 * fq + 4);
#pragma unroll
            for (int ai = 0; ai < 2; ++ai)
#pragma unroll
                for (int m = 0; m < 4; ++m)
#pragma unroll
                    for (int bj = 0; bj < 2; ++bj) {
                        const f32x4 pp = *(const LAS f32x4*)(P + (ai * HALF + wr * 64 + m * 16 + fr) * 8 + bj * 4);
                        const float rstd = rsqrtf(((pp[0] + pp[1]) + (pp[2] + pp[3])) * (1.f / 128.f) + RMS_EPS);
                        const f32x4 v0 = acc[ai][bj][m][0] * rstd * g0, v1 = acc[ai][bj][m][1] * rstd * g1;
                        u32x4 w; w.x = cvt_pk_bf16(v0[0], v0[1]); w.y = cvt_pk_bf16(v0[2], v0[3]); w.z = cvt_pk_bf16(v1[0], v1[1]); w.w = cvt_pk_bf16(v1[2], v1[3]);
                        *(u32x4*)(base + (size_t)(ai * HALF + m * 16) * INW + bj * HALF) = w;
                        asm volatile("" ::: "memory");
                    }
        } else {
#pragma unroll
            for (int ai = 0; ai < 2; ++ai)
#pragma unroll
                for (int m = 0; m < 4; ++m)
#pragma unroll
                    for (int bj = 0; bj < 2; ++bj) {
                        const f32x4 v0 = acc[ai][bj][m][0], v1 = acc[ai][bj][m][1];
                        u32x4 w; w.x = cvt_pk_bf16(v0[0], v0[1]); w.y = cvt_pk_bf16(v0[2], v0[3]); w.z = cvt_pk_bf16(v1[0], v1[1]); w.w = cvt_pk_bf16(v1[2], v1[3]);
                        *(u32x4*)(base + (size_t)(ai * HALF + m * 16) * INW + bj * HALF) = w;
                    }
        }
    }
};
struct EpiResid {
    static constexpr bool PERM = false, ADJ = false, PREFETCH = false;
    const float* x; const float* gate;   float* out;
    __device__ __forceinline__ void operator()(f32x4 (&acc)[2][2][4][2], const Unit& u, int wr, int wc, int fr, int fq) const {
        const int col0 = u.pn * BM + wc * 32 + 4 * fq; const int b = (u.pm * BM) >> 11;
        f32x4 gv[2][2];
#pragma unroll
        for (int bj = 0; bj < 2; ++bj)
#pragma unroll
            for (int n = 0; n < 2; ++n) gv[bj][n] = *(const f32x4*)(gate + b * 12288 + col0 + bj * HALF + n * 16);
#pragma unroll
        for (int ai = 0; ai < 2; ++ai) {
            f32x4 xv[4][2][2];
#pragma unroll
            for (int m = 0; m < 4; ++m) { const size_t off = (size_t)(u.pm * BM + ai * HALF + wr * 64 + m * 16 + fr) * D + col0;
#pragma unroll
                for (int bj = 0; bj < 2; ++bj)
#pragma unroll
                    for (int n = 0; n < 2; ++n) xv[m][bj][n] = __builtin_nontemporal_load((const f32x4*)(x + off + bj * HALF + n * 16)); }
            asm volatile("" ::: "memory");
#pragma unroll
            for (int m = 0; m < 4; ++m) { const size_t off = (size_t)(u.pm * BM + ai * HALF + wr * 64 + m * 16 + fr) * D + col0;
#pragma unroll
                for (int bj = 0; bj < 2; ++bj)
#pragma unroll
                    for (int n = 0; n < 2; ++n) *(f32x4*)(out + off + bj * HALF + n * 16) = xv[m][bj][n] + gv[bj][n] * acc[ai][bj][m][n]; }
            asm volatile("" ::: "memory");
        }
    }
};
struct EpiSwiglu {
    static constexpr bool PERM = true, ADJ = false, PREFETCH = true;
    const float* bgu; unsigned char* act; LAS unsigned char* epi; const int* list; const LAS int* base;
    __device__ __forceinline__ void prefetch(const Unit& u, int slot, int lane) const {
        const float* src = bgu + (size_t)u.e * 4096 + u.pn * HALF + (lane < 32 ? lane * 4 : 2048 + (lane - 32) * 4);
        __builtin_amdgcn_global_load_lds((const unsigned*)src, (LAS unsigned*)(epi + slot * 4096), 16, 0, 0);
        const char* le = (const char*)list + ((size_t)u.e * 16384 + (size_t)(u.pm * BM - base[u.e])) * 8 + lane * 16;
        __builtin_amdgcn_global_load_lds((const unsigned*)le, (LAS unsigned*)(epi + slot * 4096 + 1024), 16, 0, 0);
        __builtin_amdgcn_global_load_lds((const unsigned*)(le + 1024), (LAS unsigned*)(epi + slot * 4096 + 2048), 16, 0, 0);
    }
    __device__ __forceinline__ void operator()(f32x4 (&acc)[2][2][4][2], const Unit& u, int wr, int wc, int fr, int fq, int slot) const {
        const int col0 = u.pn * HALF + wc * 32 + 8 * fq;
        const LAS float* bs = (const LAS float*)(epi + slot * 4096) + wc * 32 + 8 * fq;
        f32x4 bg[2], bu[2];
#pragma unroll
        for (int n = 0; n < 2; ++n) { bg[n] = *(const LAS f32x4*)(bs + 4 * n); bu[n] = *(const LAS f32x4*)(bs + 128 + 4 * n); }
#pragma unroll
        for (int ai = 0; ai < 2; ++ai)
#pragma unroll
            for (int m = 0; m < 4; ++m) {
                f32x4 o[2];
#pragma unroll
                for (int n = 0; n < 2; ++n) {
                    const f32x4 gg = acc[ai][0][m][n] + bg[n], uu = acc[ai][1][m][n] + bu[n];
                    f32x4 g, uc, e, r;
#pragma unroll
                    for (int j = 0; j < 4; ++j) { g[j] = fminf(gg[j], 7.f); uc[j] = fminf(fmaxf(uu[j], -7.f), 7.f); }
                    const f32x4 sg = g * (-1.702f * 1.4426950408889634f);
#pragma unroll
                    for (int j = 0; j < 4; ++j) e[j] = __builtin_amdgcn_exp2f(sg[j]);
                    const f32x4 den = e + 1.f;
#pragma unroll
                    for (int j = 0; j < 4; ++j) r[j] = __builtin_amdgcn_rcpf(den[j]);
                    o[n] = ((uc + 1.f) * g) * r; }
                u32x2 w; w.x = pk4_fp8(o[0][0], o[0][1], o[0][2], o[0][3]); w.y = pk4_fp8(o[1][0], o[1][1], o[1][2], o[1][3]);
                *(u32x2*)(act + (size_t)(u.pm * BM + ai * HALF + wr * 64 + m * 16 + fr) * DFF + col0) = w;
            }
    }
};
struct EpiDown {
    static constexpr bool PERM = true, ADJ = true, PREFETCH = true;
    const float* bdn; unsigned char* Y; const LAS int* base; const LAS int* cnt; const int* list; LAS unsigned char* epi;
    __device__ __forceinline__ void prefetch(const Unit& u, int slot, int lane) const {
        LAS unsigned char* s = epi + slot * 4096;
        __builtin_amdgcn_global_load_lds((const unsigned*)(bdn + (size_t)u.e * D + u.pn * BM + lane * 4), (LAS unsigned*)s, 16, 0, 0);
        const char* le = (const char*)list + ((size_t)u.e * 16384 + (size_t)(u.pm * BM - base[u.e])) * 8 + lane * 16;
        __builtin_amdgcn_global_load_lds((const unsigned*)le, (LAS unsigned*)(s + 1024), 16, 0, 0);
        __builtin_amdgcn_global_load_lds((const unsigned*)(le + 1024), (LAS unsigned*)(s + 2048), 16, 0, 0);
    }
    __device__ __forceinline__ void operator()(f32x4 (&acc)[2][2][4][2], const Unit& u, int wr, int wc, int fr, int fq, int slot) const {
        const int col0 = u.pn * BM + wc * 64 + 8 * fq;
        const LAS unsigned char* s = epi + slot * 4096;
        const LAS float* bs = (const LAS float*)s + wc * 64 + 8 * fq;
        f32x4 bv[2][2];
#pragma unroll
        for (int bj = 0; bj < 2; ++bj)
#pragma unroll
            for (int n = 0; n < 2; ++n) bv[bj][n] = *(const LAS f32x4*)(bs + bj * 32 + 4 * n);
        const int row0 = wr * 64 + fr; const int nvalid = cnt[u.e] - (u.pm * BM - base[u.e]);
        const LAS u32x2* le = (const LAS u32x2*)(s + 1024);
#pragma unroll
        for (int ai = 0; ai < 2; ++ai)
#pragma unroll
            for (int m = 0; m < 4; ++m) { const int rl = row0 + ai * HALF + m * 16;
                if (rl < nvalid) { const u32x2 ent = le[rl]; const int code = (int)ent.x; const float g = __uint_as_float(ent.y) * (float)(1 << YSH);
#pragma unroll
                    for (int bj = 0; bj < 2; ++bj) { const f32x4 v0 = (acc[ai][bj][m][0] + bv[bj][0]) * g, v1 = (acc[ai][bj][m][1] + bv[bj][1]) * g;
                        u32x2 w; w.x = pk4_fp8(v0[0], v0[1], v0[2], v0[3]); w.y = pk4_fp8(v1[0], v1[1], v1[2], v1[3]);
                        *(u32x2*)(Y + (size_t)code * D + col0 + bj * 32) = w; } } }
    }
};
}
namespace att {
constexpr int NW = 8, QBLK = 32, KVBLK = 64, LDQ = INW;
constexpr float SCALE = 0.088388347648318440f;
constexpr float ISCALE = 11.313708498984761f;
constexpr float THR = 8.f;
constexpr float NEGBIG = -1.0e30f;
constexpr int SHM_V = KVBLK * 128 * 2, SHM_K = KVBLK * 128 * 2;
constexpr int T5N = 447, T5C = 223;
constexpr int KSTG = 3, VSTG = 4;
constexpr int OFF_K = 0, OFF_V = KSTG * SHM_K, OFF_WS = OFF_V + VSTG * SHM_V, OFF_T5 = OFF_WS + NW * 64 * 4, OFF_RPB = OFF_T5 + 4 * T5N * 4;
constexpr int OFF_RPB_A = ((OFF_RPB + 15) & ~15) + 256, ATT_LDS_END = OFF_RPB_A + 8 * 465 * 4 + 256;
static_assert(ATT_LDS_END <= LDSCTL_OFF, "attention LDS (the exchange / gain areas above the ring are free during the attention phase)");
#define KSWZ(row, colB) ((row) * 256 + ((colB) ^ (((row) & 7) << 4)))
#define SBAR() __builtin_amdgcn_sched_barrier(0)
__device__ __forceinline__ int crow(int r, int hi) { return (r & 3) + 8 * (r >> 2) + 4 * hi; }

struct TileCtx {
    int mode;
    const LAS float* tab;
    int qw0;
    int r0, c0, kb16, rs_u;
};
__device__ __forceinline__ float tile_bias(f32x16& p0, f32x16& p1, const TileCtx& c, int t, int hi, int r32) {
    const int k0 = t * KVBLK;
    if (k0 - (c.qw0 + 31) >= 128) return c.tab[T5C + 128];
    if (k0 + 63 - c.qw0 <= -128) return c.tab[T5C - 128];
    int z = 0; asm volatile("" : "+v"(z));
    const LAS float* tb = c.tab + (T5C + k0 - c.qw0) + (4 * hi - r32 + z);
#pragma unroll
    for (int g = 0; g < 4; ++g) {
#pragma unroll
        for (int rr = 0; rr < 4; ++rr) { const int r = g * 4 + rr; p0[r] += tb[rr + 8 * g]; p1[r] += tb[rr + 8 * g + 32]; }
        asm volatile("" ::: "memory");
    }
    return 0.f;
}
__device__ __forceinline__ void tile_bias_nat(f32x16& p0, const TileCtx& c, int t, int hi, int r32) {
    int z = 0; asm volatile("" : "+v"(z));
    const int q = r32 + z, grow = c.r0 + (q >> 3), gcol = c.c0 + (q & 7), krow = c.rs_u + t;
    const bool inband = (unsigned)(krow - min(max(grow - 4, 0), 24)) < 8u;
    const int ro = min(max(krow - grow + 7, 0), 14), cs = min(max(gcol - 8, 0), 48);
    const int t0 = c.kb16 + 4 * hi - cs;
    const LAS float* tb = c.tab + ro * 31 + 15 - gcol + c.kb16 + 4 * hi;
#pragma unroll
    for (int g = 0; g < 4; ++g) {
#pragma unroll
        for (int rr = 0; rr < 4; ++rr) { const int r = g * 4 + rr, kr = rr + 8 * g;
            const bool in0 = inband && (unsigned)(t0 + kr) < 16u; const float b0 = tb[kr];
            p0[r] = in0 ? p0[r] + b0 : NEGBIG; }
        asm volatile("" ::: "memory");
    }
}
__device__ __forceinline__ void partialSM(f32x16& p0, f32x16& p1, float cb, float& m_reg, float& mn, float& alpha) {
    constexpr float C = SCALE * 1.4426950408889634f;
    float pmax = p0[0];
#pragma unroll
    for (int r = 1; r < 16; ++r) pmax = fmaxf(pmax, p0[r]);
#pragma unroll
    for (int r = 0; r < 16; ++r) pmax = fmaxf(pmax, p1[r]);
    { auto rr = __builtin_amdgcn_permlane32_swap(__float_as_uint(pmax), __float_as_uint(pmax), false, false);
      pmax = fmaxf(__uint_as_float(rr[0]), __uint_as_float(rr[1])); }
    pmax += cb;
    if (__builtin_expect(__all(pmax - m_reg <= THR / SCALE), 1)) { mn = m_reg; alpha = 1.f; }
    else { mn = fmaxf(m_reg, pmax); alpha = __builtin_amdgcn_exp2f((m_reg - mn) * C); m_reg = mn; }
    const float mnC = (cb - mn) * C;
#pragma unroll
    for (int r = 0; r < 16; ++r) p0[r] = fmaf(p0[r], C, mnC);
#pragma unroll
    for (int r = 0; r < 16; ++r) p1[r] = fmaf(p1[r], C, mnC);
#pragma unroll
    for (int r = 0; r < 16; ++r) p0[r] = __builtin_amdgcn_exp2f(p0[r]);
}
__device__ __forceinline__ void finishSM(f32x16& p0, f32x16& p1, float alpha, float& l_reg, bf16x8& pa0, bf16x8& pa1, bf16x8& pa2, bf16x8& pa3) {
#pragma unroll
    for (int r = 0; r < 16; ++r) p1[r] = __builtin_amdgcn_exp2f(p1[r]);
    float ps = 0;
#pragma unroll
    for (int r = 0; r < 16; ++r) ps += p0[r];
#pragma unroll
    for (int r = 0; r < 16; ++r) ps += p1[r];
    { auto rr = __builtin_amdgcn_permlane32_swap(__float_as_uint(ps), __float_as_uint(ps), false, false);
      ps = __uint_as_float(rr[0]) + __uint_as_float(rr[1]); }
    l_reg = l_reg * alpha + ps;
#define PK4(P, BASE, OUT) do { unsigned a0 = cvt_pk_bf16(P[BASE + 0], P[BASE + 1]), a1 = cvt_pk_bf16(P[BASE + 2], P[BASE + 3]);   \
    unsigned b0 = cvt_pk_bf16(P[BASE + 4], P[BASE + 5]), b1 = cvt_pk_bf16(P[BASE + 6], P[BASE + 7]);                              \
    auto r0 = __builtin_amdgcn_permlane32_swap(a0, b0, false, false); auto r1 = __builtin_amdgcn_permlane32_swap(a1, b1, false, false); \
    u32x4 w = {r0[0], r1[0], r0[1], r1[1]}; OUT = *reinterpret_cast<bf16x8*>(&w); } while (0)
    PK4(p0, 0, pa0); PK4(p0, 8, pa1); PK4(p1, 0, pa2); PK4(p1, 8, pa3);
#undef PK4
}
__device__ __forceinline__ void qkt(f32x16& p0, f32x16& p1, const LAS char* Ks, const bf16x8* qr, int r32, int hi) {
    p0 = f32x16{}; p1 = f32x16{};
#pragma unroll
    for (int d0 = 0; d0 < 8; ++d0) { const int cb = (d0 * 16 + hi * 8) * 2;
        const bf16x8 b0 = *reinterpret_cast<const LAS bf16x8*>(Ks + KSWZ(r32, cb));
        const bf16x8 b1 = *reinterpret_cast<const LAS bf16x8*>(Ks + KSWZ(32 + r32, cb));
        p0 = __builtin_amdgcn_mfma_f32_32x32x16_bf16(b0, qr[d0], p0, 0, 0, 0);
        p1 = __builtin_amdgcn_mfma_f32_32x32x16_bf16(b1, qr[d0], p1, 0, 0, 0); }
}
__device__ __forceinline__ int v_st(int k, int c) { const int kk = (k & ~0xC) | ((k & 4) << 1) | ((k & 8) >> 1); return ((kk >> 3) * 4 + (c >> 5)) * 512 + ((kk & 7) * 32 + (c & 31)) * 2; }
__device__ __forceinline__ int v_rd_base(int lane) { return ((lane & 3) << 3) | (((lane >> 2) & 3) << 6) | (((lane >> 4) & 1) << 5) | (((lane >> 5) & 1) << 8); }
constexpr int v_rd_off(int d0, int ks, int half) { return d0 * 512 + ks * 4096 + half * 2048; }
template <int OFF> __device__ __forceinline__ s16x4 tr_read(int vb) {
    s16x4 r; asm volatile("ds_read_b64_tr_b16 %0, %1 offset:%2" : "=&v"(r) : "v"(vb), "i"(OFF) : "memory"); return r;
}
template <int D0> __device__ __forceinline__ void pv_one(f32x16& od, int vb, bf16x8 pa0, bf16x8 pa1, bf16x8 pa2, bf16x8 pa3) {
    const s16x4 l0 = tr_read<v_rd_off(D0, 0, 0)>(vb), h0 = tr_read<v_rd_off(D0, 0, 1)>(vb), l1 = tr_read<v_rd_off(D0, 1, 0)>(vb), h1 = tr_read<v_rd_off(D0, 1, 1)>(vb);
    const s16x4 l2 = tr_read<v_rd_off(D0, 2, 0)>(vb), h2 = tr_read<v_rd_off(D0, 2, 1)>(vb), l3 = tr_read<v_rd_off(D0, 3, 0)>(vb), h3 = tr_read<v_rd_off(D0, 3, 1)>(vb);
    asm volatile("s_waitcnt lgkmcnt(0)" ::: "memory"); SBAR();
#define PK(L, H) (bf16x8){L[0], L[1], L[2], L[3], H[0], H[1], H[2], H[3]}
    od = __builtin_amdgcn_mfma_f32_32x32x16_bf16(pa0, PK(l0, h0), od, 0, 0, 0);
    od = __builtin_amdgcn_mfma_f32_32x32x16_bf16(pa1, PK(l1, h1), od, 0, 0, 0);
    od = __builtin_amdgcn_mfma_f32_32x32x16_bf16(pa2, PK(l2, h2), od, 0, 0, 0);
    od = __builtin_amdgcn_mfma_f32_32x32x16_bf16(pa3, PK(l3, h3), od, 0, 0, 0);
#undef PK
}
__device__ __forceinline__ void pv_d0(f32x16* o, int vb, bf16x8 pa0, bf16x8 pa1, bf16x8 pa2, bf16x8 pa3) {
    pv_one<0>(o[0], vb, pa0, pa1, pa2, pa3); pv_one<1>(o[1], vb, pa0, pa1, pa2, pa3); pv_one<2>(o[2], vb, pa0, pa1, pa2, pa3); pv_one<3>(o[3], vb, pa0, pa1, pa2, pa3);
}

__device__ __forceinline__ void partialSM_h(f32x16& p0, float& m_reg, float& mn, float& alpha) {
    constexpr float C = SCALE * 1.4426950408889634f;
    float pmax = p0[0];
#pragma unroll
    for (int r = 1; r < 16; ++r) pmax = fmaxf(pmax, p0[r]);
    { auto rr = __builtin_amdgcn_permlane32_swap(__float_as_uint(pmax), __float_as_uint(pmax), false, false);
      pmax = fmaxf(__uint_as_float(rr[0]), __uint_as_float(rr[1])); }
    if (__builtin_expect(__all(pmax - m_reg <= THR / SCALE), 1)) { mn = m_reg; alpha = 1.f; }
    else { mn = fmaxf(m_reg, pmax); alpha = __builtin_amdgcn_exp2f((m_reg - mn) * C); m_reg = mn; }
    const float mnC = -mn * C;
#pragma unroll
    for (int r = 0; r < 16; ++r) p0[r] = __builtin_amdgcn_exp2f(fmaf(p0[r], C, mnC));
}
__device__ __forceinline__ void finishSM_h(f32x16& p0, float alpha, float& l_reg, bf16x8& pa0, bf16x8& pa1) {
    float ps = 0;
#pragma unroll
    for (int r = 0; r < 16; ++r) ps += p0[r];
    { auto rr = __builtin_amdgcn_permlane32_swap(__float_as_uint(ps), __float_as_uint(ps), false, false);
      ps = __uint_as_float(rr[0]) + __uint_as_float(rr[1]); }
    l_reg = l_reg * alpha + ps;
#define PK4(P, BASE, OUT) do { unsigned a0 = cvt_pk_bf16(P[BASE + 0], P[BASE + 1]), a1 = cvt_pk_bf16(P[BASE + 2], P[BASE + 3]);   \
    unsigned b0 = cvt_pk_bf16(P[BASE + 4], P[BASE + 5]), b1 = cvt_pk_bf16(P[BASE + 6], P[BASE + 7]);                              \
    auto r0 = __builtin_amdgcn_permlane32_swap(a0, b0, false, false); auto r1 = __builtin_amdgcn_permlane32_swap(a1, b1, false, false); \
    u32x4 w = {r0[0], r1[0], r0[1], r1[1]}; OUT = *reinterpret_cast<bf16x8*>(&w); } while (0)
    PK4(p0, 0, pa0); PK4(p0, 8, pa1);
#undef PK4
}
__device__ __forceinline__ void qkt_h(f32x16& p0, const LAS char* Ks, const bf16x8* qr, int r32, int hi) {
    p0 = f32x16{};
#pragma unroll
    for (int d0 = 0; d0 < 8; ++d0) { const int cb = (d0 * 16 + hi * 8) * 2;
        const bf16x8 b0 = *reinterpret_cast<const LAS bf16x8*>(Ks + KSWZ(r32, cb));
        p0 = __builtin_amdgcn_mfma_f32_32x32x16_bf16(b0, qr[d0], p0, 0, 0, 0); }
}
template <int D0> __device__ __forceinline__ void pv_one_h(f32x16& od, int vb, bf16x8 pa0, bf16x8 pa1) {
    s16x4 l0 = tr_read<v_rd_off(D0, 0, 0)>(vb), h0 = tr_read<v_rd_off(D0, 0, 1)>(vb), l1 = tr_read<v_rd_off(D0, 1, 0)>(vb), h1 = tr_read<v_rd_off(D0, 1, 1)>(vb);
    asm volatile("s_waitcnt lgkmcnt(0)" : "+v"(l0), "+v"(h0), "+v"(l1), "+v"(h1) :: "memory");
#define PK(L, H) (bf16x8){L[0], L[1], L[2], L[3], H[0], H[1], H[2], H[3]}
    od = __builtin_amdgcn_mfma_f32_32x32x16_bf16(pa0, PK(l0, h0), od, 0, 0, 0);
    od = __builtin_amdgcn_mfma_f32_32x32x16_bf16(pa1, PK(l1, h1), od, 0, 0, 0);
#undef PK
}
__device__ __forceinline__ void pv_h(f32x16* o, int vb, bf16x8 pa0, bf16x8 pa1) {
    pv_one_h<0>(o[0], vb, pa0, pa1); pv_one_h<1>(o[1], vb, pa0, pa1); pv_one_h<2>(o[2], vb, pa0, pa1); pv_one_h<3>(o[3], vb, pa0, pa1);
}

template <int MODE>
__device__ __forceinline__ void attn_pass(const bf16_t* __restrict__ Qb, const bf16_t* __restrict__ Kh, const bf16_t* __restrict__ Vh, int NT, int tbase, int tmax,
                                          const TileCtx& ctx, LAS char* lds, f32x16 (&o)[4]) {
    int tid = threadIdx.x; asm volatile("" : "+v"(tid));
    const int wid = __builtin_amdgcn_readfirstlane(tid >> 6), lane = tid & 63, r32 = lane & 31, hi = lane >> 5;
    LAS char* V_lds = lds + OFF_V; LAS char* K_lds = lds + OFF_K;
    LAS float* wsl = (LAS float*)(lds + OFF_WS) + wid * 64; LAS float* li_l = wsl; LAS float* al_l = wsl + 32;
    float m_reg = -1e30f, l_reg = 0;
#pragma unroll
    for (int d = 0; d < 4; ++d) o[d] = f32x16{};
    unsigned kso[2], vso[2];
#pragma unroll
    for (int i = 0; i < 2; ++i) { const int P = i * 8192 + tid * 16;
        { const int row = P >> 8, cbp = P & 255, cb = cbp ^ ((row & 7) << 4); kso[i] = (unsigned)(row * LDQ * 2 + cb); }
        { const int sub = P >> 9, within = P & 511, kk = (sub >> 2) * 8 + (within >> 6), c = (sub & 3) * 32 + ((within & 63) >> 1);
          const int k = (kk & ~0xC) | ((kk & 4) << 1) | ((kk & 8) >> 1); vso[i] = (unsigned)(k * LDQ * 2 + c * 2); } }
    const int vb0 = (int)(uintptr_t)V_lds + v_rd_base(lane);
    const unsigned dmaw = (unsigned)wid * 1024u;
#define KROWB(t) ((size_t)(min(tbase + (t), tmax) * KVBLK) * LDQ * 2)
#define ISSUE(t, ks, vs) do { const size_t ro_ = KROWB(t); const char* kb_ = (const char*)Kh + ro_; const char* vb_ = (const char*)Vh + ro_; \
    _Pragma("unroll") for (int i_ = 0; i_ < 2; ++i_) { \
        __builtin_amdgcn_global_load_lds((const unsigned*)(kb_ + kso[i_]), (LAS unsigned*)(K_lds + (ks) * SHM_K + i_ * 8192 + dmaw), 16, 0, 0); \
        __builtin_amdgcn_global_load_lds((const unsigned*)(vb_ + vso[i_]), (LAS unsigned*)(V_lds + (vs) * SHM_V + i_ * 8192 + dmaw), 16, 0, 0); } } while (0)
#define TOP(n) asm volatile("s_waitcnt vmcnt(" #n ") lgkmcnt(0)\n\ts_barrier" ::: "memory")
#define RESC(a) do { if (__any((a) < 1.f)) { if (hi == 0) al_l[r32] = (a); asm volatile("s_waitcnt lgkmcnt(0)" ::: "memory"); \
    _Pragma("unroll") for (int d = 0; d < 4; ++d) _Pragma("unroll") for (int r = 0; r < 16; ++r) o[d][r] *= al_l[crow(r, hi)]; } } while (0)
#define ADV3(x) ((x) == 2 ? 0 : (x) + 1)
#define ADV4(x) (((x) + 1) & 3)
    bf16x8 qr[8];
    const bf16_t* Qw = Qb + (size_t)(MODE == 0 ? wid * QBLK + r32 : (r32 >> 3) * 64 + ctx.c0 + (r32 & 7)) * LDQ + hi * 8;
    const int kboff = ctx.kb16 * 256, vkoff = (ctx.kb16 >> 4) * 4096;
#pragma unroll
    for (int d0 = 0; d0 < 8; ++d0) qr[d0] = *reinterpret_cast<const bf16x8*>(Qw + d0 * 16);
    f32x16 pA0, pA1, pB0, pB1; float mnA, mnB, alA, alB, cbA, cbB; bf16x8 pa0, pa1, pa2, pa3;
#define QKT(P0, P1) do { if constexpr (MODE == 0) qkt(P0, P1, K_lds + kq * SHM_K, qr, r32, hi); else qkt_h(P0, K_lds + kq * SHM_K + kboff, qr, r32, hi); kq = ADV3(kq); } while (0)
#define PSM(P0, P1, cb_, mn_, al_, t_) do { if constexpr (MODE == 0) { cb_ = tile_bias(P0, P1, ctx, (t_), hi, r32); partialSM(P0, P1, cb_, m_reg, mn_, al_); } \
        else { tile_bias_nat(P0, ctx, (t_), hi, r32); partialSM_h(P0, m_reg, mn_, al_); } } while (0)
#define FSM(P0, P1, al_) do { if constexpr (MODE == 0) finishSM(P0, P1, al_, l_reg, pa0, pa1, pa2, pa3); else finishSM_h(P0, al_, l_reg, pa0, pa1); } while (0)
#define PVS() do { if constexpr (MODE == 0) pv_d0(o, vb0 + vq * SHM_V, pa0, pa1, pa2, pa3); else pv_h(o, vb0 + vq * SHM_V + vkoff, pa0, pa1); vq = ADV4(vq); } while (0)
    asm volatile("s_waitcnt lgkmcnt(0)\n\ts_barrier" ::: "memory");
    ISSUE(0, 0, 0); ISSUE(1, 1, 1);
    int kq = 0, vq = 0;
    int ki = 2, vi = 2;
    TOP(4); ISSUE(2, ki, vi); ki = ADV3(ki); vi = ADV4(vi);
    QKT(pA0, pA1); PSM(pA0, pA1, cbA, mnA, alA, 0);
    for (int j = 1; j + 1 < NT; j += 2) {
        TOP(4); ISSUE(j + 2, ki, vi); ki = ADV3(ki); vi = ADV4(vi);
        SBAR(); QKT(pB0, pB1);
        FSM(pA0, pA1, alA); SBAR();
        PVS(); PSM(pB0, pB1, cbB, mnB, alB, j);
        RESC(alB);
        if (j + 3 < NT) { TOP(4); ISSUE(j + 3, ki, vi); ki = ADV3(ki); vi = ADV4(vi); } else { TOP(0); }
        SBAR(); QKT(pA0, pA1);
        FSM(pB0, pB1, alB); SBAR();
        PVS(); PSM(pA0, pA1, cbA, mnA, alA, j + 1);
        RESC(alA);
    }
    TOP(0);
    SBAR(); QKT(pB0, pB1);
    FSM(pA0, pA1, alA); SBAR();
    PVS(); PSM(pB0, pB1, cbB, mnB, alB, NT - 1);
    RESC(alB);
    FSM(pB0, pB1, alB); SBAR();
    PVS();
    if (hi == 0) li_l[r32] = l_reg; asm volatile("s_waitcnt lgkmcnt(0)" ::: "memory");
#pragma unroll
    for (int r = 0; r < 16; ++r) { const float rl = __builtin_amdgcn_rcpf(li_l[crow(r, hi)]);
#pragma unroll
        for (int d = 0; d < 4; ++d) o[d][r] *= rl; }
#undef KROWB
#undef ISSUE
#undef TOP
#undef RESC
#undef ADV3
#undef ADV4
#undef QKT
#undef PSM
#undef FSM
#undef PVS
}

struct VFrag { s16x4 l0, h0, l1, h1; };
template <int D0> __device__ __forceinline__ void pv8_read(VFrag& f, int vb) {
    f.l0 = tr_read<v_rd_off(D0, 0, 0)>(vb); f.h0 = tr_read<v_rd_off(D0, 0, 1)>(vb); f.l1 = tr_read<v_rd_off(D0, 1, 0)>(vb); f.h1 = tr_read<v_rd_off(D0, 1, 1)>(vb);
}
template <int NLEFT> __device__ __forceinline__ void pv8_mma(f32x16& od, VFrag& f, bf16x8 pa0, bf16x8 pa1) {
    if constexpr (NLEFT == 8) asm volatile("s_waitcnt lgkmcnt(8)" : "+v"(f.l0), "+v"(f.h0), "+v"(f.l1), "+v"(f.h1) :: "memory");
    else if constexpr (NLEFT == 4) asm volatile("s_waitcnt lgkmcnt(4)" : "+v"(f.l0), "+v"(f.h0), "+v"(f.l1), "+v"(f.h1) :: "memory");
    else asm volatile("s_waitcnt lgkmcnt(0)" : "+v"(f.l0), "+v"(f.h0), "+v"(f.l1), "+v"(f.h1) :: "memory");
#define PK(L, H) (bf16x8){L[0], L[1], L[2], L[3], H[0], H[1], H[2], H[3]}
    od = __builtin_amdgcn_mfma_f32_32x32x16_bf16(pa0, PK(f.l0, f.h0), od, 0, 0, 0);
    od = __builtin_amdgcn_mfma_f32_32x32x16_bf16(pa1, PK(f.l1, f.h1), od, 0, 0, 0);
#undef PK
}
__device__ __forceinline__ void pv8_h(f32x16* o, int vbA, int vbB, bf16x8 pa0, bf16x8 pa1) {
    VFrag f0, f1, f2;
    asm volatile("s_waitcnt lgkmcnt(0)" ::: "memory");
    pv8_read<0>(f0, vbA); pv8_read<1>(f1, vbA);
    pv8_read<2>(f2, vbA); pv8_mma<8>(o[0], f0, pa0, pa1);
    pv8_read<3>(f0, vbA); pv8_mma<8>(o[1], f1, pa0, pa1);
    pv8_read<0>(f1, vbB); pv8_mma<8>(o[2], f2, pa0, pa1);
    pv8_read<1>(f2, vbB); pv8_mma<8>(o[3], f0, pa0, pa1);
    pv8_read<2>(f0, vbB); pv8_mma<8>(o[4], f1, pa0, pa1);
    pv8_read<3>(f1, vbB); pv8_mma<8>(o[5], f2, pa0, pa1);
    pv8_mma<4>(o[6], f0, pa0, pa1);
    pv8_mma<0>(o[7], f1, pa0, pa1);
}
__device__ __forceinline__ float tile_bias_hw(f32x16& p0, const TileCtx& c, int t, int hf, int hi, int r32) {
    const int k0 = t * KVBLK + hf * 32;
    if (k0 - (c.qw0 + 31) >= 128) return c.tab[T5C + 128];
    if (k0 + 31 - c.qw0 <= -128) return c.tab[T5C - 128];
    int z = 0; asm volatile("" : "+v"(z));
    const LAS float* tb = c.tab + (T5C + k0 - c.qw0) + (4 * hi - r32 + z);
#pragma unroll
    for (int g = 0; g < 4; ++g) {
#pragma unroll
        for (int rr = 0; rr < 4; ++rr) { const int r = g * 4 + rr; p0[r] += tb[rr + 8 * g]; }
        asm volatile("" ::: "memory");
    }
    return 0.f;
}
__device__ __forceinline__ void partialSM_hc(f32x16& p0, float cb, float& m_reg, float& mn, float& alpha) {
    constexpr float C = SCALE * 1.4426950408889634f;
    float pmax = p0[0];
#pragma unroll
    for (int r = 1; r < 16; ++r) pmax = fmaxf(pmax, p0[r]);
    { auto rr = __builtin_amdgcn_permlane32_swap(__float_as_uint(pmax), __float_as_uint(pmax), false, false);
      pmax = fmaxf(__uint_as_float(rr[0]), __uint_as_float(rr[1])); }
    pmax += cb;
    if (__builtin_expect(__all(pmax - m_reg <= THR / SCALE), 1)) { mn = m_reg; alpha = 1.f; }
    else { mn = fmaxf(m_reg, pmax); alpha = __builtin_amdgcn_exp2f((m_reg - mn) * C); m_reg = mn; }
    const float mnC = (cb - mn) * C;
#pragma unroll
    for (int r = 0; r < 16; ++r) p0[r] = __builtin_amdgcn_exp2f(fmaf(p0[r], C, mnC));
}
__device__ __forceinline__ void attn_pass_w(const bf16_t* __restrict__ Qb, const bf16_t* __restrict__ Kh, const bf16_t* __restrict__ Vh, int NT, const TileCtx& ctx, LAS char* lds, f32x16 (&o)[8], float (&rl)[16]) {
    int tid = threadIdx.x; asm volatile("" : "+v"(tid));
    const int wid = __builtin_amdgcn_readfirstlane(tid >> 6), lane = tid & 63, r32 = lane & 31, hi = lane >> 5;
    LAS char* K_lds = lds; LAS char* V_lds = lds + 32768;
    LAS float* wsl = (LAS float*)(lds + OFF_WS) + wid * 64; LAS float* li_l = wsl; LAS float* al_l = wsl + 32;
    float m_reg = -1e30f, l_reg = 0;
#pragma unroll
    for (int d = 0; d < 8; ++d) o[d] = f32x16{};
    unsigned kso[2], vso[2];
#pragma unroll
    for (int i = 0; i < 2; ++i) { const int P = i * 8192 + tid * 16;
        { const int row = P >> 8, cbp = P & 255, cb = cbp ^ ((row & 7) << 4); kso[i] = (unsigned)(row * LDQ * 2 + cb); }
        { const int sub = P >> 9, within = P & 511, kk = (sub >> 2) * 8 + (within >> 6), c = (sub & 3) * 32 + ((within & 63) >> 1);
          const int k = (kk & ~0xC) | ((kk & 4) << 1) | ((kk & 8) >> 1); vso[i] = (unsigned)(k * LDQ * 2 + c * 2); } }
    const int vb0 = (int)(uintptr_t)V_lds + v_rd_base(lane);
    const unsigned dmaw = (unsigned)wid * 1024u;
#define ISSUEW(t, st) do { const size_t ro_ = (size_t)((t) * KVBLK) * LDQ * 2; const char* kb_ = (const char*)Kh + ro_; const char* vb_ = (const char*)Vh + ro_; \
    _Pragma("unroll") for (int i_ = 0; i_ < 2; ++i_) { \
        __builtin_amdgcn_global_load_lds((const unsigned*)(kb_ + kso[i_]), (LAS unsigned*)(K_lds + (st) * 16384 + i_ * 8192 + dmaw), 16, 0, 0); \
        __builtin_amdgcn_global_load_lds((const unsigned*)(vb_ + vso[i_]), (LAS unsigned*)(V_lds + (st) * 32768 + i_ * 8192 + dmaw), 16, 0, 0); \
        __builtin_amdgcn_global_load_lds((const unsigned*)(vb_ + 256 + vso[i_]), (LAS unsigned*)(V_lds + (st) * 32768 + 16384 + i_ * 8192 + dmaw), 16, 0, 0); } } while (0)
    bf16x8 qr[8];
    const bf16_t* Qw = Qb + (size_t)(wid * QBLK + r32) * LDQ + hi * 8;
#pragma unroll
    for (int d0 = 0; d0 < 8; ++d0) qr[d0] = *reinterpret_cast<const bf16x8*>(Qw + d0 * 16);
    asm volatile("s_waitcnt lgkmcnt(0)\n\ts_barrier" ::: "memory");
    ISSUEW(0, 0);
    if (wid >= 4) __builtin_amdgcn_s_setprio(1);
#pragma unroll 1
    for (int t = 0; t < NT; ++t) {
        asm volatile("s_waitcnt vmcnt(0) lgkmcnt(0)\n\ts_barrier" ::: "memory");
        const int st = t & 1;
        f32x16 pq[2];
        qkt(pq[0], pq[1], K_lds + st * 16384, qr, r32, hi);
        if (t + 1 < NT) ISSUEW(t + 1, st ^ 1);
        float mn0, al0, mn1, al1; bf16x8 pa00, pa01, pa10, pa11;
        const float cb0 = tile_bias_hw(pq[0], ctx, t, 0, hi, r32);
        const float cb1 = tile_bias_hw(pq[1], ctx, t, 1, hi, r32);
        partialSM_hc(pq[0], cb0, m_reg, mn0, al0);
        finishSM_h(pq[0], al0, l_reg, pa00, pa01);
#define RESC8(al_) do { if (__any((al_) < 1.f)) { if (hi == 0) al_l[r32] = (al_); asm volatile("s_waitcnt lgkmcnt(0)" ::: "memory"); \
            _Pragma("unroll") for (int r = 0; r < 16; ++r) { const float a = al_l[crow(r, hi)]; _Pragma("unroll") for (int d = 0; d < 8; ++d) o[d][r] *= a; } } } while (0)
        RESC8(al0);
        pv8_h(o, vb0 + st * 32768, vb0 + st * 32768 + 16384, pa00, pa01);
        partialSM_hc(pq[1], cb1, m_reg, mn1, al1);
        finishSM_h(pq[1], al1, l_reg, pa10, pa11);
        RESC8(al1);
        pv8_h(o, vb0 + st * 32768 + 8192, vb0 + st * 32768 + 16384 + 8192, pa10, pa11);
#undef RESC8
    }
    __builtin_amdgcn_s_setprio(0);
    if (hi == 0) li_l[r32] = l_reg; asm volatile("s_waitcnt lgkmcnt(0)" ::: "memory");
#pragma unroll
    for (int r = 0; r < 16; ++r) rl[r] = __builtin_amdgcn_rcpf(li_l[crow(r, hi)]);
#undef ISSUEW
}
}
struct Args { const float* in[22]; float* out; unsigned char* ws; int ph_lo, ph_hi, flags, pad; };
constexpr int NPHASE = 9;

__device__ __forceinline__ int t5_bucket(int rel) {
    const int ret = rel > 0 ? 16 : 0; const int n = rel < 0 ? -rel : rel;
    int v;
    if (n < 8) v = n; else if (n < 12) v = 8; else if (n < 16) v = 9; else if (n < 23) v = 10; else if (n < 32) v = 11; else if (n < 46) v = 12; else if (n < 64) v = 13; else if (n < 91) v = 14; else v = 15;
    return ret + v;
}

template <bool F8, bool GUPERM>
__device__ __forceinline__ void transpose_range(const float* __restrict__ W, int K, int N, unsigned char* __restrict__ WT, int rlo, int rhi, float scale, int gw, int NGW, LAS float* scr, int lane, int dbg = 0) {
    const int nblk = N / 32, ipe = (K / 64) * nblk, nitems = rhi;
    const int lr = lane >> 3, lc = (lane & 7) * 4;
    const unsigned loff = (unsigned)(lr * N + lc) * 4u;
    f32x4 v0[8], v1[8], v2[8], v3[8];
    const int npw = (nitems - (rlo + 2 * gw) + 2 * NGW - 1) / (2 * NGW);
    if (nitems - (rlo + 2 * gw) <= 0) return;
    const int rlast = rlo + 2 * gw + (npw - 1) * 2 * NGW;
    int r0 = rlo + 2 * gw, r2 = r0 + 2 * NGW;
#define TR_KB(rr_) (2 * ((rr_) / (2 * nblk)) + ((rr_) & 1))
#define TR_NB(rr_) (((rr_) % (2 * nblk)) >> 1)
#define TR_LOAD(v_, r_) do { const int ru_ = __builtin_amdgcn_readfirstlane(min((r_), rlast + ((r_) & 1))); const int e_ = ru_ / ipe, rr_ = ru_ % ipe; \
        const char* ub_ = (const char*)W + ((size_t)e_ * K * N + (size_t)(TR_KB(rr_) * 64) * N + TR_NB(rr_) * 32) * 4;     \
        _Pragma("unroll") for (int i_ = 0; i_ < 8; ++i_) asm volatile("global_load_dwordx4 %0, %1, %2 nt" : "=v"(v_[i_]) : "v"(loff), "s"(ub_ + (size_t)(8 * i_) * N * 4) : "memory"); } while (0)
#define TR_WAIT() do { if (more_) asm volatile("s_waitcnt vmcnt(24)" ::: "memory"); else asm volatile("s_waitcnt vmcnt(0)" ::: "memory"); } while (0)
#define TR_WRITE(v_, sc_) do { _Pragma("unroll") for (int i_ = 0; i_ < 8; ++i_) { LAS float* d_ = (sc_) + (8 * i_ + lr) * 33 + lc; d_[0] = v_[i_][0]; d_[1] = v_[i_][1]; d_[2] = v_[i_][2]; d_[3] = v_[i_][3]; } } while (0)
#define TR_P4(b_) pk4_fp8(s[(b_) * 33] * scale, s[((b_) + 1) * 33] * scale, s[((b_) + 2) * 33] * scale, s[((b_) + 3) * 33] * scale)
#define TR_EMIT2(rc_, s0_, s1_) do { \
        const int e_ = (rc_) / ipe, rr_ = (rc_) % ipe, k0_ = TR_KB(rr_) * 64, n0_ = TR_NB(rr_) * 32; \
        const int drow0_ = GUPERM ? ((n0_ & 2047) >> 7) * 256 + (n0_ >> 11) * 128 + (n0_ & 127) : n0_; \
        if constexpr (F8) { const int n = lane >> 1, h = lane & 1; const LAS float* s = (h ? (s1_) : (s0_)) + n; u32x4 o0, o1, o2, o3; \
            o0.x = TR_P4(0); o0.y = TR_P4(4); o0.z = TR_P4(8); o0.w = TR_P4(12); o1.x = TR_P4(16); o1.y = TR_P4(20); o1.z = TR_P4(24); o1.w = TR_P4(28); \
            o2.x = TR_P4(32); o2.y = TR_P4(36); o2.z = TR_P4(40); o2.w = TR_P4(44); o3.x = TR_P4(48); o3.y = TR_P4(52); o3.z = TR_P4(56); o3.w = TR_P4(60); \
            unsigned char* dst = WT + ((((size_t)e_ * (N / 256) + (drow0_ >> 8)) * (K / 128) + (k0_ >> 7)) << 15) + ((drow0_ & 255) + n) * 128 + 64 * h;     \
            if (!(dbg & 2)) { *(u32x4*)dst = o0; *(u32x4*)(dst + 16) = o1; *(u32x4*)(dst + 32) = o2; *(u32x4*)(dst + 48) = o3; } } \
        else { const int c8 = lane & 7; \
            _Pragma("unroll") for (int hh = 0; hh < 2; ++hh) _Pragma("unroll") for (int jj = 0; jj < 4; ++jj) { const int n = (lane >> 3) + 8 * jj; const LAS float* s = (hh ? (s1_) : (s0_)) + (8 * c8) * 33 + n; \
                u32x4 o; o.x = cvt_pk_bf16(s[0 * 33], s[1 * 33]); o.y = cvt_pk_bf16(s[2 * 33], s[3 * 33]); o.z = cvt_pk_bf16(s[4 * 33], s[5 * 33]); o.w = cvt_pk_bf16(s[6 * 33], s[7 * 33]); \
                *(u32x4*)(WT + (((size_t)e_ * N + drow0_ + n) * K + k0_ + 64 * hh + 8 * c8) * 2) = o; } } } while (0)
#define TR_PAIR(va_, vb_, ra_) do { const int rca_ = min((ra_), rlast); LAS float* s1_ = scr + 64 * 33; \
        TR_WAIT(); TR_WRITE(va_, scr); if (more_) TR_LOAD(va_, (ra_) + 4 * NGW); TR_WAIT(); TR_WRITE(vb_, s1_); if (more_) TR_LOAD(vb_, (ra_) + 4 * NGW + 1); \
        LDS_WAIT(); asm volatile("" ::: "memory"); \
        TR_EMIT2(rca_, scr, s1_); \
        LDS_WAIT(); asm volatile("" ::: "memory"); } while (0)
    TR_LOAD(v0, r0); TR_LOAD(v1, r0 + 1); TR_LOAD(v2, r2); TR_LOAD(v3, r2 + 1);
    for (int it = 0; it < npw; it += 2) {
        const bool more_ = it + 2 < npw;
        TR_PAIR(v0, v1, r0); r0 += 4 * NGW;
        TR_PAIR(v2, v3, r2); r2 += 4 * NGW;
    }
    asm volatile("s_waitcnt vmcnt(0)" ::: "memory");
#undef TR_PAIR
#undef TR_WAIT
#undef TR_EMIT2
#undef TR_P4
#undef TR_WRITE
#undef TR_LOAD
#undef TR_NB
#undef TR_KB
}
template <bool GUPERM>
__device__ __forceinline__ void transpose_range_f8(const float* __restrict__ W, int K, int N, unsigned char* __restrict__ WT, int rlo, int rhi, float scale, int gw, int NGW, LAS unsigned* scr, int lane) {
    const int nblk = N / 32, ipe = (K / 64) * nblk, nitems = rhi;
    const int kg = lane >> 3, c = lane & 7;
    const unsigned loff = (unsigned)(4 * kg * N + 4 * c) * 4u;
    f32x4 v0[8], v1[8], v2[8], v3[8];
    const int npw = (nitems - (rlo + 2 * gw) + 2 * NGW - 1) / (2 * NGW);
    if (nitems - (rlo + 2 * gw) <= 0) return;
    int r0 = rlo + 2 * gw, r2 = r0 + 2 * NGW;
    constexpr int TS = 32 * 20;
#define TR_KB(rr_) (2 * ((rr_) / (2 * nblk)) + ((rr_) & 1))
#define TR_NB(rr_) (((rr_) % (2 * nblk)) >> 1)
#define T8_LOAD(v_, r_) do { const int ru_ = __builtin_amdgcn_readfirstlane(r_); const int e_ = ru_ / ipe, rr_ = ru_ % ipe; \
        const char* ub_ = (const char*)W + ((size_t)e_ * K * N + (size_t)(TR_KB(rr_) * 64) * N + TR_NB(rr_) * 32) * 4; \
        _Pragma("unroll") for (int i_ = 0; i_ < 8; ++i_) asm volatile("global_load_dwordx4 %0, %1, %2 nt" : "=v"(v_[i_]) : "v"(loff), "s"(ub_ + (size_t)(32 * (i_ >> 2) + (i_ & 3)) * N * 4) : "memory"); } while (0)
#define T8_WAIT() do { if (more_) asm volatile("s_waitcnt vmcnt(24)" ::: "memory"); else asm volatile("s_waitcnt vmcnt(0)" ::: "memory"); } while (0)
#define T8_WRITE(v_, t_) do { _Pragma("unroll") for (int q_ = 0; q_ < 2; ++q_) _Pragma("unroll") for (int m_ = 0; m_ < 4; ++m_) \
        (t_)[(4 * c + m_) * 20 + 8 * q_ + kg] = pk4_fp8(v_[4 * q_][m_] * scale, v_[4 * q_ + 1][m_] * scale, v_[4 * q_ + 2][m_] * scale, v_[4 * q_ + 3][m_] * scale); } while (0)
#define T8_PAIR(va_, vb_, ra_, t0_) do { const int rca_ = (ra_); LAS unsigned* t1_ = (t0_) + TS; \
        T8_WAIT(); T8_WRITE(va_, t0_); if (more_) T8_LOAD(va_, rca_ + 4 * NGW); T8_WAIT(); T8_WRITE(vb_, t1_); if (more_) T8_LOAD(vb_, rca_ + 4 * NGW + 1); \
        LDS_WAIT(); asm volatile("" ::: "memory"); \
        { const int e_ = rca_ / ipe, rr_ = rca_ % ipe, k0_ = TR_KB(rr_) * 64, n0_ = TR_NB(rr_) * 32; \
          const int drow0_ = GUPERM ? ((n0_ & 2047) >> 7) * 256 + (n0_ >> 11) * 128 + (n0_ & 127) : n0_; \
            \
          const int n = lane >> 3, h = (lane >> 2) & 1, sub = lane & 3; const LAS u32x4* s = (const LAS u32x4*)((h ? t1_ : (t0_)) + n * 20 + sub * 4); \
          const u32x4 o0 = s[0], o1 = s[40], o2 = s[80], o3 = s[120]; \
          unsigned char* dst = WT + ((((size_t)e_ * (N / 256) + (drow0_ >> 8)) * (K / 128) + (k0_ >> 7)) << 15) + (drow0_ & 255) * 128 + lane * 16; \
            \
          __builtin_nontemporal_store(o0, (u32x4*)dst); __builtin_nontemporal_store(o1, (u32x4*)(dst + 1024)); __builtin_nontemporal_store(o2, (u32x4*)(dst + 2048)); __builtin_nontemporal_store(o3, (u32x4*)(dst + 3072)); } } while (0)
    T8_LOAD(v0, r0); T8_LOAD(v1, r0 + 1);
    if (npw > 1) { T8_LOAD(v2, r2); T8_LOAD(v3, r2 + 1); }
    for (int it = 0; it < npw; it += 2) {
        { const bool more_ = it + 2 < npw; T8_PAIR(v0, v1, r0, scr); r0 += 4 * NGW; }
        if (it + 1 < npw) { const bool more_ = it + 3 < npw; T8_PAIR(v2, v3, r2, scr + 2 * TS); r2 += 4 * NGW; }
    }
    asm volatile("s_waitcnt vmcnt(0) lgkmcnt(0)" ::: "memory");
#undef T8_PAIR
#undef T8_WRITE
#undef T8_WAIT
#undef T8_LOAD
#undef TR_NB
#undef TR_KB
}
__device__ __forceinline__ void adaln_unit(int unit, const float* __restrict__ c, const float* __restrict__ w_ada, float* __restrict__ modp, LAS float* lds) {
    const int nc = unit % 24, kc = unit / 24, tid = threadIdx.x;
    LAS float* sc = lds; LAS float* red = lds + 2048;
    __syncthreads();
    for (int i = tid; i < 2048; i += 512) { const int k = i >> 3, b = i & 7; const float v = c[b * 2048 + kc * 256 + k]; sc[i] = v / (1.f + expf(-v)); }
    __syncthreads();
    const int c4 = tid & 127, ks = tid >> 7;
    f32x4 acc[8];
#pragma unroll
    for (int b = 0; b < 8; ++b) acc[b] = (f32x4){0.f, 0.f, 0.f, 0.f};
    const float* wp = w_ada + (size_t)(kc * 256) * 12288 + nc * 512 + c4 * 4;
#pragma unroll 16
    for (int j = 0; j < 64; ++j) { const int k = ks + 4 * j; const f32x4 w = __builtin_nontemporal_load((const f32x4*)(wp + (size_t)k * 12288));
        const f32x4 s0 = *(const LAS f32x4*)(sc + k * 8), s1 = *(const LAS f32x4*)(sc + k * 8 + 4);
        acc[0] += s0[0] * w; acc[1] += s0[1] * w; acc[2] += s0[2] * w; acc[3] += s0[3] * w; acc[4] += s1[0] * w; acc[5] += s1[1] * w; acc[6] += s1[2] * w; acc[7] += s1[3] * w; }
#pragma unroll
    for (int b = 0; b < 8; ++b) *(LAS f32x4*)(red + (ks * 8 + b) * 512 + c4 * 4) = acc[b];
    __syncthreads();
    for (int o = tid; o < 4096; o += 512) { const float s = (red[o] + red[4096 + o]) + (red[8192 + o] + red[12288 + o]); const int b = o >> 9, n = o & 511;
        modp[((size_t)kc * 8 + b) * 12288 + nc * 512 + n] = s; }
}
__device__ __forceinline__ float mod_value(const float* __restrict__ modp, const float* __restrict__ b_ada, int b, int n) {
    float s = b_ada[n];
#pragma unroll
    for (int kc = 0; kc < 8; ++kc) s += modp[((size_t)kc * 8 + b) * 12288 + n];
    return s;
}

__device__ __forceinline__ void norm_row2_bf16(const float* __restrict__ xrow0, bf16_t* __restrict__ orow0, const LAS float* a, const LAS float* sh, int lane) {
    const f32x4* xr0 = (const f32x4*)xrow0; const f32x4* xr1 = (const f32x4*)(xrow0 + D);
    f32x4 v0[8], v1[8]; float s0 = 0.f, s1 = 0.f;
#pragma unroll
    for (int j = 0; j < 8; ++j) { v0[j] = __builtin_nontemporal_load(xr0 + j * 64 + lane); v1[j] = __builtin_nontemporal_load(xr1 + j * 64 + lane); }
#pragma unroll
    for (int j = 0; j < 8; ++j) { s0 += (v0[j][0] * v0[j][0] + v0[j][1] * v0[j][1]) + (v0[j][2] * v0[j][2] + v0[j][3] * v0[j][3]); s1 += (v1[j][0] * v1[j][0] + v1[j][1] * v1[j][1]) + (v1[j][2] * v1[j][2] + v1[j][3] * v1[j][3]); }
#pragma unroll
    for (int o = 32; o >= 1; o >>= 1) { s0 += __shfl_xor(s0, o); s1 += __shfl_xor(s1, o); }
    const float r0 = rsqrtf(s0 * (1.f / D) + RMS_EPS), r1 = rsqrtf(s1 * (1.f / D) + RMS_EPS);
#pragma unroll
    for (int j = 0; j < 8; ++j) { const f32x4 aa = *(const LAS f32x4*)(a + (j * 64 + lane) * 4), ss4 = *(const LAS f32x4*)(sh + (j * 64 + lane) * 4);
        const f32x4 o0 = v0[j] * r0 * aa + ss4, o1 = v1[j] * r1 * aa + ss4; u32x2 w0, w1; w0.x = cvt_pk_bf16(o0[0], o0[1]); w0.y = cvt_pk_bf16(o0[2], o0[3]); w1.x = cvt_pk_bf16(o1[0], o1[1]); w1.y = cvt_pk_bf16(o1[2], o1[3]);
        *(u32x2*)(orow0 + (j * 64 + lane) * 4) = w0; *(u32x2*)(orow0 + D + (j * 64 + lane) * 4) = w1; }
}

__device__ __forceinline__ void attn_phase(const Args& args, LAS unsigned char* lds, int vcu, int G) {
    const int tid = threadIdx.x, wid = __builtin_amdgcn_readfirstlane(tid >> 6);
    unsigned char* ws = args.ws;
    LAS float* t5 = (LAS float*)(lds + att::OFF_T5); LAS float* rpbt = (LAS float*)(lds + att::OFF_RPB_A);
    __syncthreads();
    { const float* relb = args.in[13]; const float* rpb = args.in[8];
      for (int i = tid; i < 4 * att::T5N; i += 512) { const int h = i / att::T5N, rel = min(max(i % att::T5N - att::T5C, -128), 128); t5[i] = relb[t5_bucket(rel) * 4 + h] * att::ISCALE; }
      for (int i = tid; i < 8 * 465; i += 512) rpbt[i] = rpb[i] * att::ISCALE; }
    __syncthreads();
    constexpr int NDIFF = NB * 4 * 8, NNAT = NB * 8 * 8;
#define P3_CONVERT() do {\
                __syncthreads();                                       \
                int tc_ = threadIdx.x; asm volatile("" : "+v"(tc_));   \
                { const int lane_ = tc_ & 63; LAS float* scr = (LAS float*)(lds + wid * 17408); const int gw = vcu * 8 + wid, NGW = G * 8;\
                  transpose_range_f8<true>(args.in[18], D, 4096, ws + WS_WGU, GU_SPLIT3, NE * 4096, (float)(1 << WSH), gw, NGW, (LAS unsigned*)scr, lane_);\
                  transpose_range_f8<false>(args.in[20], DFF, D, ws + WS_WDN, DN_SPLIT3, NE * 2048, (float)(1 << WSH), gw, NGW, (LAS unsigned*)scr, lane_); }\
                __syncthreads();                                       \
                { const float* relb = args.in[13]; const float* rpb = args.in[8];\
                  for (int i = tc_; i < 4 * att::T5N; i += 512) { const int hh = i / att::T5N, rel = min(max(i % att::T5N - att::T5C, -128), 128); t5[i] = relb[t5_bucket(rel) * 4 + hh] * att::ISCALE; }\
                  for (int i = tc_; i < 8 * 465; i += 512) rpbt[i] = rpb[i] * att::ISCALE; }\
                __syncthreads();\
            } while (0)
    const int conv_slot = (vcu >> 3) % CONV_SLOTS; int step = 0;
    for (int u = vcu; u < NDIFF + NNAT; u += G) {
        const int mode = u < NDIFF ? 0 : 1;
        int b, h, q0, NT, tbase, npass, qoff, koff, voff, ooff;
        att::TileCtx ctx; ctx.mode = mode;
        if (mode == 0) { const int qb = u & 7; h = (u >> 3) & 3; b = u >> 5; q0 = qb * 256; NT = 32; tbase = 0; npass = 2; qoff = 3072 + h * 256; koff = 4096 + h * 256; voff = 5120 + h * 256; ooff = 1024 + h * 256;
            ctx.tab = t5 + h * att::T5N; ctx.qw0 = q0 + wid * 32; ctx.r0 = 0; ctx.c0 = 0; ctx.kb16 = 0; ctx.rs_u = 0; }
        else { const int un = u - NDIFF; const int rq = un & 7; h = (un >> 3) & 7; b = un >> 6; const int r0 = rq * 4; q0 = r0 * 64; npass = 1; qoff = h * 128; koff = 1024 + h * 128; voff = 2048 + h * 128; ooff = h * 128;
            ctx.tab = rpbt + h * 465; ctx.qw0 = 0; ctx.r0 = r0; ctx.c0 = 8 * wid; ctx.kb16 = min(max(((8 * wid - 8) >> 4) << 4, 0), 32);
            ctx.rs_u = min(max(r0 - 4, 0), 24);
            const int rs_last = min(max(r0 - 1, 0), 24); NT = (rs_last + 8 - ctx.rs_u + 1) & ~1; tbase = ctx.rs_u; }
        const bf16_t* base = (const bf16_t*)(ws + WS_QKV) + (size_t)b * S * INW;
#pragma unroll 1
        for (int pass = 0; pass < npass; ++pass) {
            if (step++ == conv_slot) { P3_CONVERT(); }
            if (mode == 0) {
                f32x16 o[8]; float rl[16];
                att::attn_pass_w(base + (size_t)q0 * INW + qoff + pass * 128, base + koff + pass * 128, base + voff, NT, ctx, (LAS char*)lds, o, rl);
                int tl = threadIdx.x; asm volatile("" : "+v"(tl));
                const int lane = tl & 63, r32 = lane & 31, hi = lane >> 5;
                const char* sb = (const char*)(ws + WS_STASH) + (size_t)blockIdx.x * (256 * 512 * 4);
                asm volatile("" : "+s"(sb));
                const unsigned svo = (unsigned)tl * 16u;
#define ST4P(j) ((__attribute__((address_space(1))) f32x4*)((__attribute__((address_space(1))) char*)sb + (size_t)(j) * 8192 + svo))
                {
#pragma unroll
                    for (int d = 0; d < 8; ++d)
#pragma unroll
                        for (int qq = 0; qq < 4; ++qq) *ST4P(pass * 32 + d * 4 + qq) = (f32x4){o[d][4 * qq] * rl[4 * qq], o[d][4 * qq + 1] * rl[4 * qq + 1], o[d][4 * qq + 2] * rl[4 * qq + 2], o[d][4 * qq + 3] * rl[4 * qq + 3]};
                }
                if (pass == 1) {
                    const float lam = ((const float*)(ws + WS_MISC))[0]; const float* subg = args.in[12];
                    float gsub[8];
#pragma unroll
                    for (int d = 0; d < 8; ++d) gsub[d] = subg[d * 32 + r32];
                    bf16_t* orow = (bf16_t*)(ws + WS_MIX) + ((size_t)b * S + q0 + wid * 32 + 4 * hi) * D + ooff + r32;
                    f32x4 a[2][8], c[2][8];
#pragma unroll
                    for (int d = 0; d < 8; ++d) { a[0][d] = *ST4P(d * 4); c[0][d] = *ST4P(32 + d * 4); }
#pragma unroll
                    for (int qq = 0; qq < 4; ++qq) { const int cur = qq & 1, nxt = cur ^ 1;
                        if (qq < 3) {
#pragma unroll
                            for (int d = 0; d < 8; ++d) { a[nxt][d] = *ST4P(d * 4 + qq + 1); c[nxt][d] = *ST4P(32 + d * 4 + qq + 1); } }
                        asm volatile("" ::: "memory");
#pragma unroll
                        for (int d = 0; d < 8; ++d) a[cur][d] = a[cur][d] - lam * c[cur][d];
#pragma unroll
                        for (int k = 0; k < 4; ++k) { float s = 0.f;
#pragma unroll
                            for (int d = 0; d < 8; ++d) s += a[cur][d][k] * a[cur][d][k];
#pragma unroll
                            for (int off = 16; off >= 1; off >>= 1) s += __shfl_xor(s, off);
                            const float rstd = rsqrtf(s * (1.f / 256.f) + RMS_EPS) * 0.8f; const int row = att::crow(4 * qq + k, 0);
#pragma unroll
                            for (int d = 0; d < 8; ++d) orow[(size_t)row * D + d * 32] = (bf16_t)(cvt_pk_bf16(a[cur][d][k] * rstd * gsub[d], 0.f) & 0xffffu); }
                        asm volatile("" ::: "memory"); }
                }
#undef ST4P
            } else {
                f32x16 o[4];
                att::attn_pass<1>(base + (size_t)q0 * INW + qoff, base + koff, base + voff, NT, tbase, 31, ctx, (LAS char*)lds, o);
                int tl = threadIdx.x; asm volatile("" : "+v"(tl));
                const int lane = tl & 63, r32 = lane & 31, hi = lane >> 5;
                bf16_t* onat = (bf16_t*)(ws + WS_MIX) + ((size_t)b * S + q0 + 8 * wid + 4 * hi) * D + ooff + r32;
#pragma unroll
                for (int r = 0; r < 16; ++r) { const int row = (r >> 2) * 64 + (r & 3);
#pragma unroll
                    for (int d = 0; d < 4; ++d) onat[(size_t)row * D + d * 32] = (bf16_t)(cvt_pk_bf16(o[d][r], 0.f) & 0xffffu); }
            }
        }
    }
    if (step <= conv_slot) { P3_CONVERT(); }
#undef P3_CONVERT
}

__device__ __forceinline__ void router_phase(const Args& args, LAS unsigned char* lds, int vcu, int G) {
    const int tid = threadIdx.x, wid = __builtin_amdgcn_readfirstlane(tid >> 6), lane = tid & 63;
    unsigned char* ws = args.ws;
    const float* x1 = args.out; const float* g2 = args.in[15]; const float* rw = args.in[16]; const float* rb = args.in[17];
    const float* mod = (const float*)(ws + WS_MOD);
    unsigned char* H2 = (unsigned char*)(ws + WS_H2); unsigned* cnt = (unsigned*)(ws + WS_CTL) + CW_CNT; int* list = (int*)(ws + WS_LIST); float* gate = (float*)(ws + WS_GATE);
    LAS float* a = (LAS float*)lds; LAS float* sh = a + 2048; LAS float* rs = sh + 2048  ; LAS float* part = rs + 64  ;
    LAS float* stg = part + 4 * 64 * 33 + wid * (32 * 68);
    int curb = -1;
    for (int u = vcu; u < M / 64; u += G) {
        const int row0 = u * 64, b = row0 >> 11;
        __syncthreads();
        if (b != curb) { curb = b;
            for (int i = tid; i < 2048; i += 512) { a[i] = g2[i] * (1.f + mod[b * 12288 + 8192 + i]); sh[i] = mod[b * 12288 + 6144 + i]; }
            __syncthreads(); }
#pragma unroll 1
        for (int i = 0; i < 8; i += 4) { const int row = row0 + wid * 8 + i;
            const f32x4* xr = (const f32x4*)(x1 + (size_t)row * D);
            f32x4 v[4][8]; float s[4];
#pragma unroll
            for (int j = 0; j < 8; ++j)
#pragma unroll
                for (int rr = 0; rr < 4; ++rr) v[rr][j] = xr[rr * (D / 4) + j * 64 + lane];
#pragma unroll
            for (int rr = 0; rr < 4; ++rr) { s[rr] = 0.f;
#pragma unroll
                for (int j = 0; j < 8; ++j) s[rr] += (v[rr][j][0] * v[rr][j][0] + v[rr][j][1] * v[rr][j][1]) + (v[rr][j][2] * v[rr][j][2] + v[rr][j][3] * v[rr][j][3]); }
#pragma unroll
            for (int o = 32; o >= 1; o >>= 1) {
#pragma unroll
                for (int rr = 0; rr < 4; ++rr) s[rr] += __shfl_xor(s[rr], o); }
            float rstd[4];
#pragma unroll
            for (int rr = 0; rr < 4; ++rr) rstd[rr] = rsqrtf(s[rr] * (1.f / D) + RMS_EPS);
            if (lane == 0) {
#pragma unroll
                for (int rr = 0; rr < 4; ++rr) rs[wid * 8 + i + rr] = rstd[rr]; }
            unsigned char* orow = H2 + (size_t)row * D;
#pragma unroll
            for (int j = 0; j < 8; ++j) { const f32x4 aa = *(const LAS f32x4*)(a + (j * 64 + lane) * 4), s4 = *(const LAS f32x4*)(sh + (j * 64 + lane) * 4);
#pragma unroll
                for (int rr = 0; rr < 4; ++rr) { const f32x4 o0 = v[rr][j] * rstd[rr] * aa + s4;
                    *(unsigned*)(orow + (size_t)rr * D + (j * 64 + lane) * 4) = pk4_fp8(o0[0], o0[1], o0[2], o0[3]); } } }
        __syncthreads();
        { const int tt = wid & 1, kq = wid >> 1; const int tok = lane & 31, kh = lane >> 5;
          const int sr = lane >> 4, sc = (lane & 15) * 4;
          const float* xb = x1 + (size_t)(row0 + tt * 32 + sr) * D + kq * 512 + sc;
          const float* wp = rw + (size_t)(kq * 512 + 4 * kh) * 32 + tok;
          f32x4 xn[8];
#pragma unroll
          for (int i = 0; i < 8; ++i) xn[i] = *(const f32x4*)(xb + (size_t)(4 * i) * D);
          f32x16 acc = f32x16{};
          float wn[32];
#pragma unroll
          for (int q = 0; q < 32; ++q) wn[q] = wp[(size_t)(8 * (q >> 2) + (q & 3)) * 32];
#pragma unroll 1
          for (int ch = 0; ch < 8; ++ch) {
              const int kb = kq * 512 + ch * 64;
              { const f32x4 aa = *(const LAS f32x4*)(a + kb + sc), s4 = *(const LAS f32x4*)(sh + kb + sc);
#pragma unroll
                for (int i = 0; i < 8; ++i) { const float rstd = rs[tt * 32 + 4 * i + sr]; *(LAS f32x4*)(stg + (4 * i + sr) * 68 + sc) = xn[i] * rstd * aa + s4; } }
              if (ch + 1 < 8) {
#pragma unroll
                  for (int i = 0; i < 8; ++i) xn[i] = *(const f32x4*)(xb + (size_t)(4 * i) * D + (ch + 1) * 64); }
              float w[32];
#pragma unroll
              for (int q = 0; q < 32; ++q) w[q] = wn[q];
              if (ch + 1 < 8) {
#pragma unroll
                  for (int q = 0; q < 32; ++q) wn[q] = wp[(size_t)((ch + 1) * 64 + 8 * (q >> 2) + (q & 3)) * 32]; }
#pragma unroll
              for (int m = 0; m < 8; ++m) { const f32x4 hv = *(const LAS f32x4*)(stg + tok * 68 + 8 * m + 4 * kh);
                  acc = __builtin_amdgcn_mfma_f32_32x32x2f32(hv[0], w[4 * m + 0], acc, 0, 0, 0);
                  acc = __builtin_amdgcn_mfma_f32_32x32x2f32(hv[1], w[4 * m + 1], acc, 0, 0, 0);
                  acc = __builtin_amdgcn_mfma_f32_32x32x2f32(hv[2], w[4 * m + 2], acc, 0, 0, 0);
                  acc = __builtin_amdgcn_mfma_f32_32x32x2f32(hv[3], w[4 * m + 3], acc, 0, 0, 0); }
          }
#pragma unroll
          for (int r = 0; r < 16; ++r) part[(kq * 64 + tt * 32 + att::crow(r, kh)) * 33 + tok] = acc[r];
        }
        __syncthreads();
        if (wid == 0) {
            float lg[32];
#pragma unroll
            for (int e = 0; e < 32; ++e) lg[e] = ((part[(0 * 64 + lane) * 33 + e] + part[(1 * 64 + lane) * 33 + e]) + (part[(2 * 64 + lane) * 33 + e] + part[(3 * 64 + lane) * 33 + e])) + rb[e];
            int idx[4]; float val[4];
#pragma unroll
            for (int k = 0; k < 4; ++k) {
                float bv = -3.0e38f; int bi = 0;
#pragma unroll
                for (int e = 0; e < 32; ++e) { const bool take = lg[e] > bv; bv = take ? lg[e] : bv; bi = take ? e : bi; }
                idx[k] = bi; val[k] = bv;
#pragma unroll
                for (int e = 0; e < 32; ++e) lg[e] = (e == bi) ? -3.0e38f : lg[e];
            }
            const float e1 = expf(val[1] - val[0]), e2 = expf(val[2] - val[0]), e3 = expf(val[3] - val[0]);
            const float inv = 1.f / (1.f + e1 + e2 + e3);
            const float gk[4] = {inv, e1 * inv, e2 * inv, e3 * inv};
            LAS unsigned* hist = (LAS unsigned*)rs;
            if (lane < 32) hist[lane] = 0u;
            asm volatile("s_waitcnt lgkmcnt(0)" ::: "memory");
            unsigned rank[4];
#pragma unroll
            for (int k = 0; k < 4; ++k) rank[k] = __hip_atomic_fetch_add(hist + idx[k], 1u, __ATOMIC_RELAXED, __HIP_MEMORY_SCOPE_WORKGROUP);
            asm volatile("s_waitcnt lgkmcnt(0)" ::: "memory");
            if (lane < 32) { const unsigned c = hist[lane]; hist[32 + lane] = c ? atomicAdd(&cnt[lane * 32], c) : 0u; }
            asm volatile("s_waitcnt vmcnt(0) lgkmcnt(0)" ::: "memory");
            const int row = row0 + lane;
#pragma unroll
            for (int k = 0; k < 4; ++k) { const unsigned pos = hist[32 + idx[k]] + rank[k]; *(u32x2*)(list + (idx[k] * 16384 + pos) * 2) = (u32x2){(unsigned)(row * 4 + k), __float_as_uint(gk[k])}; }
        }
    }
}

__device__ __forceinline__ int moe_tables(const unsigned* __restrict__ cntg, LAS int* tb) {
    LAS int* base = tb; LAS int* cn = tb + 40; LAS int* tile_e = tb + 80;
    __syncthreads();
    if (threadIdx.x == 0) { int acc = 0; for (int e = 0; e < 32; ++e) { const int c = (int)__hip_atomic_load(cntg + e * 32, RLX_AGENT); base[e] = acc; cn[e] = c; acc += (c + 255) & ~255; } base[32] = acc; }
    __syncthreads();
    const int nt = base[32] >> 8;
    for (int t = threadIdx.x; t < nt; t += 512) { int e = 0; while (base[e + 1] <= t * 256) ++e; tile_e[t] = e; }
    __syncthreads();
    return nt;
}
__global__ void __launch_bounds__(512, 2) fwd(Args args) {
    extern __shared__ __attribute__((aligned(16))) unsigned char lds_raw[];
    LAS unsigned char* lds = (LAS unsigned char*)lds_raw;
    volatile LAS unsigned* MISC = (volatile LAS unsigned*)(lds + LDSCTL_OFF);
    const int tid = threadIdx.x, lane = tid & 63, wave = __builtin_amdgcn_readfirstlane(tid >> 6);
    const int G = gridDim.x; const int bx = blockIdx.x; const int vcu = (G % 8 == 0) ? (bx % 8) * (G / 8) + bx / 8 : bx;
    unsigned char* ws = args.ws;
    unsigned* ctl = (unsigned*)(ws + WS_CTL);
    for (int u = tid; u < 64; u += 512) ((LAS unsigned*)(lds + LDSCTL_OFF))[u] = 0u;
    __syncthreads();
    XcdBarrier bar = xcd_barrier_post(ctl + CW_BAR, MISC + 8);
    const int lo = args.ph_lo, hi = args.ph_hi;
#ifndef PHASES
#define PHASES 0x1ff
#endif
#define IN(k) (((PHASES >> (k)) & 1) && lo <= (k) && (k) < hi)
#define BOTH(k) (IN(k) && IN((k) + 1))
#ifndef DUPMASK
#define DUPMASK 0
#endif
#define NREP(k) ((((DUPMASK) >> (k)) & 1) + 1)
#define PHASE_BEGIN(k) if (IN(k)) { _Pragma("unroll") for (int rep_ = 0; rep_ < NREP(k); ++rep_) {
#define PHASE_END(k) if (BOTH(k) || rep_ + 1 < NREP(k)) GRID_BAR(); } }
#define GRID_BAR() xcd_barrier(bar)
    const float* x = args.in[0];
    float* modp = (float*)(ws + WS_MODP); float* mod = (float*)(ws + WS_MOD);
    bf16_t* WinT = (bf16_t*)(ws + WS_WIN); bf16_t* WoT = (bf16_t*)(ws + WS_WO); unsigned char* WguT = ws + WS_WGU; unsigned char* WdnT = ws + WS_WDN;
    bf16_t* XN = (bf16_t*)(ws + WS_XN); bf16_t* QKV = (bf16_t*)(ws + WS_QKV); bf16_t* MIX = (bf16_t*)(ws + WS_MIX); unsigned char* H2 = ws + WS_H2;
    unsigned char* ACT = ws + WS_ACT; unsigned char* Y = ws + WS_Y;

    PHASE_BEGIN(0)
        for (int u = vcu; u < 192; u += G) adaln_unit(u, args.in[1], args.in[2], modp, (LAS float*)lds);
        __syncthreads();
        if (bx == 0 && wave == 0) { const float* lam = args.in[11];
            float a = lam[lane] * lam[128 + lane] + lam[64 + lane] * lam[192 + lane];
            float b = lam[256 + lane] * lam[384 + lane] + lam[320 + lane] * lam[448 + lane];
            a = wave_sum(a); b = wave_sum(b);
            if (lane == 0) ((float*)(ws + WS_MISC))[0] = expf(a) - expf(b) + 0.2f; }
        LAS float* scr = (LAS float*)(lds + wave * 17408);
        const int gw = vcu * 8 + wave, NGW = G * 8;
        transpose_range<false, false>(args.in[5], D, INW, (unsigned char*)WinT, 0, 32 * 192, 1.f, gw, NGW, scr, lane);
        transpose_range<false, false>(args.in[14], D, D, (unsigned char*)WoT, 0, 32 * 64, 1.f, gw, NGW, scr, lane);
        transpose_range_f8<true>(args.in[18], D, 4096, WguT, 0, (args.flags & 16) ? NE * 4096 : GU_SPLIT, (float)(1 << WSH), gw, NGW, (LAS unsigned*)scr, lane);
        transpose_range_f8<false>(args.in[20], DFF, D, WdnT, 0, (args.flags & 16) ? NE * 2048 : DN_SPLIT, (float)(1 << WSH), gw, NGW, (LAS unsigned*)scr, lane);
    PHASE_END(0)
    PHASE_BEGIN(1)
        for (int i = vcu * 512 + tid; i < 8 * 12288; i += G * 512) mod[i] = mod_value(modp, args.in[3], i / 12288, i % 12288);
        LAS float* a = (LAS float*)lds; LAS float* sh = a + 2048;
        int curb = -1;
        for (int u = vcu; u < M / 64; u += G) {
            const int b = u >> 5;
            if (b != curb) { curb = b; __syncthreads();
                for (int i = tid; i < 2048; i += 512) { a[i] = args.in[4][i] * (1.f + mod_value(modp, args.in[3], b, 2048 + i)); sh[i] = mod_value(modp, args.in[3], b, i); }
                __syncthreads(); }
#pragma unroll 1
            for (int i = 0; i < 8; i += 2) { const int row = u * 64 + wave * 8 + i; norm_row2_bf16(x + (size_t)row * D, XN + (size_t)row * D, a, sh, lane); }
        }
    PHASE_END(1)
    PHASE_BEGIN(2)
        const bool conv = bx >= G - NCONV;
        if (conv) {
            LAS float* scr = (LAS float*)(lds + wave * 17408);
            const int gw = (bx - (G - NCONV)) * 8 + wave, NGW = NCONV * 8;
            transpose_range_f8<true>(args.in[18], D, 4096, WguT, GU_SPLIT, GU_SPLIT3, (float)(1 << WSH), gw, NGW, (LAS unsigned*)scr, lane);
            transpose_range_f8<false>(args.in[20], DFF, D, WdnT, DN_SPLIT, DN_SPLIT3, (float)(1 << WSH), gw, NGW, (LAS unsigned*)scr, lane);
            __syncthreads();
        }
        if (!(args.flags & 1)) {
        pg8::DenseSched S; S.A = XN; S.Bt = WinT; S.RB = D * 2; S.ord.init(M / 256, INW / 256, conv ? NCONV : G - NCONV, conv ? bx - (G - NCONV) : bx);
        if (conv) S.ord.lo = P2_RR * (G - NCONV); else S.ord.hi = P2_RR * (G - NCONV);
        { LAS float* gt = (LAS float*)(lds + GTAB_OFF); const int which = tid >> 7, j = tid & 127;
          gt[tid] = (which == 0 ? args.in[6] : which == 1 ? args.in[7] : which == 2 ? args.in[9] : args.in[10])[j]; }
        __syncthreads();
        pg8::EpiQKV E{QKV, (const LAS float*)(lds + GTAB_OFF), (LAS float*)(lds + EXCH_OFF)};
        pg8::gemm_phase<pg8::EpiQKV, pg8::DenseSched, true>(lds + RING_OFF, D * 2, S, E);
        }
    PHASE_END(2)
    PHASE_BEGIN(3)
        attn_phase(args, lds, vcu, G);
    PHASE_END(3)
    PHASE_BEGIN(4)
        __syncthreads();
        pg8::DenseSched S; S.A = MIX; S.Bt = WoT; S.RB = D * 2; S.ord.init(M / 256, D / 256, G, bx);
        pg8::EpiResid E{x, mod + 4096, args.out};
        pg8::gemm_phase<pg8::EpiResid, pg8::DenseSched, true>(lds + RING_OFF, D * 2, S, E);
    PHASE_END(4)
    PHASE_BEGIN(5)
        router_phase(args, lds, vcu, G);
    PHASE_END(5)
    PHASE_BEGIN(6)
        LAS int* tb = (LAS int*)(lds + EXCH_OFF);
        const int nMt = moe_tables(ctl + CW_CNT, tb);
        pg8::MoeSched<true> S; S.A = H2; S.Bt = WguT; S.RB = D; S.NperE = 4096; S.ord.init(nMt, 16, G, bx); S.tile_e = tb + 80; S.base = tb; S.cnt = tb + 40; S.list = (const int*)(ws + WS_LIST);
        pg8::EpiSwiglu E{args.in[19], ACT, lds + EPI_OFF, (const int*)(ws + WS_LIST), tb};
        pg8::gemm_phase<pg8::EpiSwiglu, pg8::MoeSched<true>, true, true, 127, 127 - WSH>(lds + RING_OFF, D, S, E);
    PHASE_END(6)
    PHASE_BEGIN(7)
        LAS int* tb = (LAS int*)(lds + EXCH_OFF);
        const int nMt = moe_tables(ctl + CW_CNT, tb);
        pg8::MoeSched<false> S; S.A = ACT; S.Bt = WdnT; S.RB = DFF; S.NperE = 2048; S.ord.init(nMt, 8, G, bx); S.tile_e = tb + 80; S.base = tb; S.cnt = tb + 40; S.list = (const int*)(ws + WS_LIST);
        pg8::EpiDown E{args.in[21], Y, tb, tb + 40, (const int*)(ws + WS_LIST), lds + EPI_OFF};
        pg8::gemm_phase<pg8::EpiDown, pg8::MoeSched<false>, true, true, 127, 127 - WSH>(lds + RING_OFF, DFF, S, E);
    PHASE_END(7)
    if (IN(8)) {
        float* out = args.out;
        constexpr float YS = 1.f / (float)(1 << YSH);
        for (int hc = vcu * 8 + wave; hc < M; hc += G * 8) {
            unsigned w[2][4][4]; f32x4 xv[2][4];
#pragma unroll
            for (int h = 0; h < 2; ++h) { const int hr = hc + h * M, row = hr >> 1, c0 = (hr & 1) * 1024 + 4 * lane;
#pragma unroll
                for (int kk = 0; kk < 4; ++kk)
#pragma unroll
                    for (int q = 0; q < 4; ++q) w[h][kk][q] = __builtin_nontemporal_load((const unsigned*)(Y + ((size_t)row * 4 + kk) * D + c0 + 256 * q));
#pragma unroll
                for (int q = 0; q < 4; ++q) xv[h][q] = __builtin_nontemporal_load((const f32x4*)(out + (size_t)row * D + c0 + 256 * q)); }
#pragma unroll
            for (int h = 0; h < 2; ++h) { const int hr = hc + h * M, row = hr >> 1, c0 = (hr & 1) * 1024 + 4 * lane, b = row >> 11;
#pragma unroll
                for (int q = 0; q < 4; ++q) {
                    f32x4 s = (f32x4){0.f, 0.f, 0.f, 0.f};
#pragma unroll
                    for (int kk = 0; kk < 4; ++kk) { const unsigned ww = w[h][kk][q];
                        const f32x2 lo = __builtin_amdgcn_cvt_pk_f32_fp8((int)ww, false), hi2 = __builtin_amdgcn_cvt_pk_f32_fp8((int)ww, true);
                        s[0] += lo[0]; s[1] += lo[1]; s[2] += hi2[0]; s[3] += hi2[1]; }
                    const f32x4 g = *(const f32x4*)(mod + b * 12288 + 10240 + c0 + 256 * q);
                    __builtin_nontemporal_store(xv[h][q] + g * (s * YS), (f32x4*)(out + (size_t)row * D + c0 + 256 * q)); }
            }
        }
    }
#undef IN
#undef BOTH
#undef GRID_BAR
}
#ifndef STAGE
#define STAGE 9
#endif
#if STAGE < 9
__global__ void __launch_bounds__(256) k_cvt_bf16_f32(const bf16_t* __restrict__ src, float* __restrict__ dst, size_t n4) {
    for (size_t i = (size_t)blockIdx.x * 256 + threadIdx.x; i < n4; i += (size_t)gridDim.x * 256) {
        const u32x2 w = ((const u32x2*)src)[i];
        ((f32x4*)dst)[i] = (f32x4){__uint_as_float(w.x << 16), __uint_as_float(w.x & 0xffff0000u), __uint_as_float(w.y << 16), __uint_as_float(w.y & 0xffff0000u)};
    }
}
#endif
extern "C" void kernel_launch(void* const* d_in, const int* in_sizes, int n_in, void* d_out, int out_size, void* d_ws, size_t ws_size, hipStream_t stream) {
    static int grid = 0;
    if (grid == 0) {
        int dev = 0, cus = 0, per_cu = 0;
        if (hipGetDevice(&dev) != hipSuccess || hipDeviceGetAttribute(&cus, hipDeviceAttributeMultiprocessorCount, dev) != hipSuccess) { fprintf(stderr, "kernel_launch: device query failed\n"); grid = -1; return; }
        if (hipFuncSetAttribute((const void*)fwd, hipFuncAttributeMaxDynamicSharedMemorySize, LDS_BYTES) != hipSuccess) { fprintf(stderr, "kernel_launch: hipFuncSetAttribute failed\n"); grid = -1; return; }
        if (hipOccupancyMaxActiveBlocksPerMultiprocessor(&per_cu, (const void*)fwd, 512, LDS_BYTES) != hipSuccess || per_cu < 1) fprintf(stderr, "kernel_launch: occupancy query reports %d\n", per_cu);
        (void)hipGetLastError();
        grid = cus;
    }
    if (grid < 0) return;
    unsigned char* ws = (unsigned char*)d_ws;
    (void)hipMemsetAsync(ws + WS_CTL, 0, CTL_ZERO_BYTES, stream);
    Args a{};
    for (int i = 0; i < 22; ++i) a.in[i] = (const float*)d_in[i];
    a.out = (float*)d_out; a.ws = ws; a.ph_lo = 0; a.ph_hi = STAGE;
    hipLaunchKernelGGL(fwd, dim3(grid), dim3(512), LDS_BYTES, stream, a);
#if STAGE < 9
    {
        using namespace orc;
        const float* x = (const float*)d_in[0];
        float* out = (float*)d_out;
        unsigned* cnt = (unsigned*)(ws + WS_CTL); float* mod = (float*)(ws + WS_MOD); float* misc = (float*)(ws + WS_MISC); float* gate = (float*)(ws + WS_GATE);
        int* list = (int*)(ws + WS_LIST); int* rowcode = (int*)(ws + WS_ROWCODE); int* tile_e = (int*)(ws + WS_TILEE);
        float* xn = (float*)(ws + WS_TEST); float* proj = (float*)(ws + WS_TEST + 128 * MiB); float* mix = (float*)(ws + WS_TEST + 512 * MiB); float* h2 = (float*)(ws + WS_TEST + 640 * MiB);
        float* act = (float*)(ws + WS_TEST + 768 * MiB); float* Y = (float*)(ws + WS_TEST + 1344 * MiB);
        const float* w_in = (const float*)d_in[5]; const float* w_out = (const float*)d_in[14]; const float* w_gu = (const float*)d_in[18]; const float* b_gu = (const float*)d_in[19];
        const float* w_dn = (const float*)d_in[20]; const float* b_dn = (const float*)d_in[21];
        if (STAGE == 2) k_cvt_bf16_f32<<<4096, 256, 0, stream>>>((const bf16_t*)(ws + WS_XN), xn, (size_t)M * D / 4);
        if (STAGE <= 2) { k_ogemm<EpiStore><<<dim3(INW / 128, M / 128), 256, 0, stream>>>(xn, D, nullptr, w_in, INW, 0, nullptr, D, nullptr, 0, EpiStore{proj, INW});
            k_qknorm<<<M * 32 / 4, 256, 0, stream>>>(proj, (const float*)d_in[6], (const float*)d_in[7], (const float*)d_in[9], (const float*)d_in[10]); }
        if (STAGE == 3) k_cvt_bf16_f32<<<4096, 256, 0, stream>>>((const bf16_t*)(ws + WS_QKV), proj, (size_t)M * INW / 4);
        if (STAGE <= 3) { k_nat<<<NB * 8 * S / 4, 256, 0, stream>>>(proj, (const float*)d_in[8], mix);
            k_diff<<<NB * 4 * 1024, 256, 0, stream>>>(proj, (const float*)d_in[13], (const float*)d_in[12], misc, mix); }
        if (STAGE == 4) k_cvt_bf16_f32<<<4096, 256, 0, stream>>>((const bf16_t*)(ws + WS_MIX), mix, (size_t)M * D / 4);
        if (STAGE <= 4) k_ogemm<EpiResid><<<dim3(D / 128, M / 128), 256, 0, stream>>>(mix, D, nullptr, w_out, D, 0, nullptr, D, nullptr, 0, EpiResid{x, mod, 4096, out});
        if (STAGE <= 5) k_router<<<M / 4, 256, 0, stream>>>(out, (const float*)d_in[15], mod, (const float*)d_in[16], (const float*)d_in[17], h2, cnt, list, gate);
        if (STAGE == 6) k_cvt_bf16_f32<<<4096, 256, 0, stream>>>((const bf16_t*)(ws + WS_H2), h2, (size_t)M * D / 4);
        if (STAGE <= 7) k_tables<<<MAXSLOT / 256, 256, 0, stream>>>(cnt, list, rowcode, tile_e);
        if (STAGE <= 6) k_ogemm<EpiSwiglu><<<dim3(DFF / 64, MAXSLOT / 128), 256, 0, stream>>>(h2, D, rowcode, w_gu, 2 * DFF, (size_t)D * 2 * DFF, tile_e, D, tile_e + 512, 2048, EpiSwiglu{b_gu, act});
        if (STAGE == 7) k_cvt_bf16_f32<<<4096, 256, 0, stream>>>((const bf16_t*)(ws + WS_ACT), act, (size_t)MAXSLOT * DFF / 4);
        if (STAGE <= 7) k_ogemm<EpiDown><<<dim3(D / 128, MAXSLOT / 128), 256, 0, stream>>>(act, DFF, nullptr, w_dn, D, (size_t)DFF * D, tile_e, DFF, tile_e + 512, 0, EpiDown{b_dn, rowcode, gate, Y});
        if (STAGE == 8) k_cvt_bf16_f32<<<4096, 256, 0, stream>>>((const bf16_t*)(ws + WS_Y), Y, (size_t)M * 4 * D / 4);
        if (STAGE <= 8) k_combine<<<M * 512 / 256, 256, 0, stream>>>(out, Y, mod);
    }
#endif
}
```
